# Optimizing an MI355X kernel written in HIP

```python
import jax, jax.numpy as jnp
from jax import lax
import numpy as np

D_MODEL = 2048
BATCH = 4
SEQ = 2048
DEPTH = 2
DEC_BATCH = 128
DEC_SEQ = 1
PAST_LEN = 16384
PAGE_SIZE = 128

MIX_DIM = D_MODEL
CONV_DIM = MIX_DIM // 2
CONV_GROUPS = 16
CONV_WIDTH = 3
GLA_HEADS = 4
GLA_V_DIM = MIX_DIM - CONV_DIM
GLA_QK_DIM = GLA_V_DIM // 2
GLA_DK = GLA_QK_DIM // GLA_HEADS
GLA_DV = GLA_V_DIM // GLA_HEADS
GATE_RANK = 16
GATE_TAU = 16.0
GLA_CHUNK = 64
D_FF = 5632
EPS = 1e-6

_S1 = CONV_DIM
_S2 = _S1 + CONV_DIM
_S3 = _S2 + CONV_DIM
_S4 = _S3 + GLA_QK_DIM
_S5 = _S4 + GLA_QK_DIM
_S6 = _S5 + GLA_V_DIM
_S7 = _S6 + GLA_V_DIM
IN_COLS = _S7 + GATE_RANK

kernel_name = "hybrid_shortconv_gla_convffn_step"


def rmsnorm(x, g):
    xf = x.astype(jnp.float32)
    var = jnp.mean(xf * xf, axis=-1, keepdims=True)
    return (xf * lax.rsqrt(var + EPS) * g.astype(jnp.float32)).astype(x.dtype)


def causal_dwconv(u, prev, w):
    full = jnp.concatenate([prev.astype(u.dtype), u], axis=1)
    L = u.shape[1]
    y = full[:, 0:L] * w[0]
    for tap in range(1, CONV_WIDTH):
        y = y + full[:, tap:tap + L] * w[tap]
    return y, full[:, -(CONV_WIDTH - 1):]


def pick_chunk(L):
    return GLA_CHUNK if L % GLA_CHUNK == 0 else L


def gla_chunked(q, k, v, logf, s0, chunk):
    B, L, H, DK = q.shape
    DV = v.shape[-1]
    n = L // chunk

    def blocks(t):
        return jnp.moveaxis(t.reshape((B, n, chunk) + t.shape[2:]), 1, 0)

    mask = jnp.tril(jnp.ones((chunk, chunk), dtype=bool))[None, :, :, None, None]

    def step(S, inp):
        qc, kc, vc, gc = inp
        b = jnp.cumsum(gc, axis=1)
        inter = jnp.einsum('bihk,bhkv->bihv', qc * jnp.exp(b), S)
        diff = b[:, :, None] - b[:, None, :]
        decay = jnp.exp(jnp.where(mask, diff, -jnp.inf))
        A = jnp.einsum('bihk,bjhk,bijhk->bhij', qc, kc, decay)
        intra = jnp.einsum('bhij,bjhv->bihv', A, vc)
        bC = b[:, -1]
        kdec = kc * jnp.exp(bC[:, None] - b)
        S_new = jnp.exp(bC)[..., None] * S + jnp.einsum('bjhk,bjhv->bhkv', kdec, vc)
        return S_new, inter + intra

    s_fin, o = lax.scan(step, s0, (blocks(q), blocks(k), blocks(v), blocks(logf)))
    o = jnp.moveaxis(o, 0, 1).reshape(B, L, H, DV)
    return o, s_fin


def mixer(xn, conv_prev, gla_prev, w_in, conv_w, gate_w2, gate_b, gla_norm_g, w_out, chunk):
    Bn, L, _ = xn.shape
    proj = xn @ w_in
    bg, cg, hin, q, k, v, og, glr = jnp.split(proj, [_S1, _S2, _S3, _S4, _S5, _S6, _S7], axis=-1)
    cu, conv_new = causal_dwconv(cg * hin, conv_prev, conv_w)
    ya = bg * cu
    f32 = jnp.float32
    logf = jax.nn.log_sigmoid((glr @ gate_w2 + gate_b).astype(f32)) / GATE_TAU
    qh = q.astype(f32).reshape(Bn, L, GLA_HEADS, GLA_DK) * (GLA_DK ** -0.5)
    kh = k.astype(f32).reshape(Bn, L, GLA_HEADS, GLA_DK)
    vh = v.astype(f32).reshape(Bn, L, GLA_HEADS, GLA_DV)
    lf = logf.reshape(Bn, L, GLA_HEADS, GLA_DK)
    o, s_new = gla_chunked(qh, kh, vh, lf, gla_prev.astype(f32), chunk)
    var = jnp.mean(o * o, axis=-1, keepdims=True)
    o = o * lax.rsqrt(var + EPS) * gla_norm_g.astype(f32).reshape(GLA_HEADS, GLA_DV)
    yb = (o.reshape(Bn, L, GLA_V_DIM) * jax.nn.silu(og.astype(f32))).astype(xn.dtype)
    out = jnp.concatenate([ya, yb], axis=-1) @ w_out
    return out, conv_new, s_new


def conv_ffn(xn, prev, w_up, conv_w, conv_b, w_down):
    u, v = jnp.split(xn @ w_up, 2, axis=-1)
    cu, new = causal_dwconv(u, prev, conv_w)
    h = jax.nn.silu(cu + conv_b) * v
    return h @ w_down, new


def trunk(x, conv_prev, gla_prev, ffn_prev, norm_mix_g, w_in, conv_w, gate_w2, gate_b,
          gla_norm_g, w_out, norm_ffn_g, w_up, ffn_conv_w, ffn_conv_b, w_down, final_norm_g):
    chunk = pick_chunk(x.shape[1])
    convs, glas, ffns = [], [], []
    for l in range(DEPTH):
        m, c_new, s_new = mixer(rmsnorm(x, norm_mix_g[l]), conv_prev[l], gla_prev[l], w_in[l],
                                conv_w[l], gate_w2[l], gate_b[l], gla_norm_g[l], w_out[l], chunk)
        x = x + m
        f, f_new = conv_ffn(rmsnorm(x, norm_ffn_g[l]), ffn_prev[l], w_up[l], ffn_conv_w[l],
                            ffn_conv_b[l], w_down[l])
        x = x + f
        convs.append(c_new)
        glas.append(s_new)
        ffns.append(f_new)
    return rmsnorm(x, final_norm_g), jnp.stack(convs), jnp.stack(glas), jnp.stack(ffns)


def setup_inputs(seed: int = 0) -> dict:
    key = jax.random.key(seed)
    ks = jax.random.split(key, 20)
    nrm = jax.random.normal
    f32 = jnp.float32
    return {
        "x_prompt": nrm(ks[0], (BATCH, SEQ, D_MODEL), f32),
        "x_sample": nrm(ks[1], (DEC_BATCH, DEC_SEQ, D_MODEL), f32),
        "state_conv": nrm(ks[2], (DEPTH, DEC_BATCH, CONV_WIDTH - 1, CONV_DIM), f32),
        "state_gla": 0.5 * nrm(ks[3], (DEPTH, DEC_BATCH, GLA_HEADS, GLA_DK, GLA_DV), f32),
        "state_ffn_conv": nrm(ks[4], (DEPTH, DEC_BATCH, CONV_WIDTH - 1, D_FF), f32),
        "norm_mix_g": 1.0 + 0.02 * nrm(ks[5], (DEPTH, D_MODEL), f32),
        "w_in": nrm(ks[6], (DEPTH, D_MODEL, IN_COLS), f32) * D_MODEL ** -0.5,
        "conv_w": nrm(ks[7], (DEPTH, CONV_WIDTH, CONV_DIM), f32) * CONV_WIDTH ** -0.5,
        "gate_w2": nrm(ks[8], (DEPTH, GATE_RANK, GLA_QK_DIM), f32) * GATE_RANK ** -0.5,
        "gate_b": 0.1 * nrm(ks[9], (DEPTH, GLA_QK_DIM), f32),
        "gla_norm_g": 1.0 + 0.02 * nrm(ks[10], (DEPTH, GLA_V_DIM), f32),
        "w_out": nrm(ks[11], (DEPTH, MIX_DIM, D_MODEL), f32) * MIX_DIM ** -0.5,
        "norm_ffn_g": 1.0 + 0.02 * nrm(ks[12], (DEPTH, D_MODEL), f32),
        "w_up": nrm(ks[13], (DEPTH, D_MODEL, 2 * D_FF), f32) * D_MODEL ** -0.5,
        "ffn_conv_w": nrm(ks[14], (DEPTH, CONV_WIDTH, D_FF), f32) * CONV_WIDTH ** -0.5,
        "ffn_conv_b": 0.02 * nrm(ks[15], (DEPTH, D_FF), f32),
        "w_down": nrm(ks[16], (DEPTH, D_FF, D_MODEL), f32) * D_FF ** -0.5,
        "final_norm_g": 1.0 + 0.02 * nrm(ks[17], (D_MODEL,), f32),
    }


def reference(x_prompt, x_sample, state_conv, state_gla, state_ffn_conv, norm_mix_g, w_in,
              conv_w, gate_w2, gate_b, gla_norm_g, w_out, norm_ffn_g, w_up, ffn_conv_w,
              ffn_conv_b, w_down, final_norm_g):
    dt = x_prompt.dtype
    zero_conv = jnp.zeros((DEPTH, BATCH, CONV_WIDTH - 1, CONV_DIM), dt)
    zero_gla = jnp.zeros((DEPTH, BATCH, GLA_HEADS, GLA_DK, GLA_DV), jnp.float32)
    zero_ffn = jnp.zeros((DEPTH, BATCH, CONV_WIDTH - 1, D_FF), dt)
    y_prompt, conv_p, gla_p, ffn_p = trunk(
        x_prompt, zero_conv, zero_gla, zero_ffn, norm_mix_g, w_in, conv_w, gate_w2, gate_b,
        gla_norm_g, w_out, norm_ffn_g, w_up, ffn_conv_w, ffn_conv_b, w_down, final_norm_g)
    y_sample, conv_s, gla_s, ffn_s = trunk(
        x_sample, state_conv, state_gla, state_ffn_conv, norm_mix_g, w_in, conv_w, gate_w2,
        gate_b, gla_norm_g, w_out, norm_ffn_g, w_up, ffn_conv_w, ffn_conv_b, w_down, final_norm_g)
    return (y_prompt, y_sample, conv_p, gla_p, ffn_p, conv_s, gla_s, ffn_s)
```

```cpp
#define TR_GATHER 1
#include <hip/hip_runtime.h>
#include <hip/hip_cooperative_groups.h>
#include <cstdio>
#include <cstdint>
namespace cg = cooperative_groups;
namespace pg8 {
#define PG8_LAS __attribute__((address_space(3)))
typedef unsigned short bf16_t;
typedef short bf16x8 __attribute__((ext_vector_type(8)));
typedef float f32x4 __attribute__((ext_vector_type(4)));
typedef unsigned u32x4 __attribute__((ext_vector_type(4)));
constexpr int BM = 256, BK = 64, HALF = 128, HTB = HALF * BK * 2  , STAGE_BYTES = 8 * HTB, NXCD = 8, WGM = 8;

__host__ __device__ __forceinline__ int lds_byte(int r, int c) { const int st = (r >> 4) * 2 + (c >> 5), rr = r & 15, cc = c & 31, ob = rr * 64 + cc * 2; return st * 1024 + (ob ^ (((ob >> 9) & 1) << 5)); }
__host__ __device__ __forceinline__ void stage_rc(int b, int& R, int& C) { const int st = b / 1024, sb = b % 1024, swz = sb ^ (((sb >> 9) & 1) << 5); R = (st >> 1) * 16 + swz / 64; C = (st & 1) * 32 + (swz % 64) / 2; }
__host__ __device__ __forceinline__ int perm32(int rho) { const int n = rho >> 4, i = rho & 15; return 8 * (i >> 2) + 4 * n + (i & 3); }

struct Unit { int pm, pn, k0, nt, sp; };
struct Gemm { const bf16_t* A; const bf16_t* Bt; int M, N, K; };

struct StaticOrder {
    int nM, nN, nwg, G, c;
    __host__ __device__ void init(int M, int N, int G_, int c_) { nM = M / BM; nN = N / BM; nwg = nM * nN; G = G_; c = c_; }
    __host__ __device__ bool next(int i, Unit& u) const {
        const long L = (long)i * G + c; if (L >= nwg) return false;
        int wgid = (int)L; { const int q = nwg / NXCD, r = nwg % NXCD, xcd = wgid % NXCD, off = wgid / NXCD; wgid = (xcd < r ? xcd * (q + 1) : r * (q + 1) + (xcd - r) * q) + off; }
        const int nig = WGM * nN, gid = wgid / nig, fm = gid * WGM, gsz = (nM - fm) < WGM ? (nM - fm) : WGM;
        u.pm = fm + ((wgid % nig) % gsz); u.pn = (wgid % nig) / gsz; u.k0 = 0; u.sp = -1; return true;
    }
    __device__ __forceinline__ void a_ready(const Unit&) const {}
    __device__ __forceinline__ void done(const Unit&) const {}
};
__device__ __forceinline__ unsigned cvt_pk_bf16(float lo, float hi) { unsigned r; asm volatile("v_cvt_pk_bf16_f32 %0, %1, %2" : "=v"(r) : "v"(lo), "v"(hi)); return r; }
typedef float f32x2 __attribute__((ext_vector_type(2)));
template <class Epi, class Sched, bool ALIGN_EPI = false, bool SP2 = false>
__device__ __forceinline__ void gemm_phase(PG8_LAS unsigned char* lds, const Gemm g, const Sched& S, const Epi& E) {
    int tid = threadIdx.x; asm volatile("" : "+v"(tid)); const int wid = __builtin_amdgcn_readfirstlane(tid >> 6), lane = tid & 63, wr = wid >> 2, wc = wid & 3, fr = lane & 15, fq = lane >> 4;
    const int K = g.K;
    unsigned voffA[2], voffB[2];
#pragma unroll
    for (int i = 0; i < 2; ++i) { int R, C; stage_rc(tid * 16 + i * 8192, R, C); const int Rb = Epi::PERM ? ((R & ~31) + perm32(R & 31)) : R;
        voffA[i] = (unsigned)(R * K + C) * 2u; voffB[i] = (unsigned)(Rb * K + C) * 2u; }
    const size_t kstep = (size_t)(BK * 2);
    const size_t hstep = (size_t)HALF * K * 2;
    const size_t tstep = 2 * hstep;
    const unsigned ldsw = (unsigned)wid * 1024u;
    const int aoff = lds_byte(wr * 64 + fr, fq * 8), boff = lds_byte(wc * 32 + fr, fq * 8);
#define PG8_SA(b, h) (((b) * 2 + (h)) * HTB)
#define PG8_SB(b, h) ((4 + (b) * 2 + (h)) * HTB)
#define PG8_STAGE(bufoff, gbase, voff) do { _Pragma("unroll") for (int _i = 0; _i < 2; ++_i) \
        __builtin_amdgcn_global_load_lds((const unsigned*)((const char*)(gbase) + (voff)[_i]), (PG8_LAS unsigned*)(lds + (bufoff) + ldsw + _i * 8192), 16, 0, 0); } while (0)
#define PG8_LDA(dst, b, h) do { _Pragma("unroll") for (int m = 0; m < 4; ++m) _Pragma("unroll") for (int k = 0; k < 2; ++k) dst[m][k] = *(const PG8_LAS bf16x8*)(lds + PG8_SA(b, h) + aoff + m * 2048 + k * 1024); } while (0)
#define PG8_LDB(dst, b, h) do { _Pragma("unroll") for (int n = 0; n < 2; ++n) _Pragma("unroll") for (int k = 0; k < 2; ++k) dst[n][k] = *(const PG8_LAS bf16x8*)(lds + PG8_SB(b, h) + boff + n * 2048 + k * 1024); } while (0)
#define PG8_MMA(ai, bj, At, Bt) do { __builtin_amdgcn_s_setprio(1); _Pragma("unroll") for (int m = 0; m < 4; ++m) _Pragma("unroll") for (int n = 0; n < 2; ++n) _Pragma("unroll") for (int k = 0; k < 2; ++k) \
        acc[ai][bj][m][n] = __builtin_amdgcn_mfma_f32_16x16x32_bf16(Bt[n][k], At[m][k], acc[ai][bj][m][n], 0, 0, 0); __builtin_amdgcn_s_setprio(0); } while (0)
#define PG8_WAIT_V(n) asm volatile("s_waitcnt vmcnt(" #n ")" ::: "memory")
#define PG8_WAIT_L(n) asm volatile("s_waitcnt lgkmcnt(" #n ")" ::: "memory")
#define PG8_BAR __builtin_amdgcn_s_barrier()
#define PG8_SCHED __builtin_amdgcn_sched_barrier(0)
    Unit cur, nxt; int ui = 0;
    if (!S.next(0, cur)) return;
    f32x4 acc[2][2][4][2];
#pragma unroll
    for (int a = 0; a < 2; ++a)
#pragma unroll
        for (int b = 0; b < 2; ++b)
#pragma unroll
            for (int m = 0; m < 4; ++m)
#pragma unroll
                for (int n = 0; n < 2; ++n) acc[a][b][m][n] = (f32x4){0.f, 0.f, 0.f, 0.f};
    bf16x8 At[4][2], B0[2][2], B1[2][2];
    const char* cA = (const char*)g.A + (size_t)cur.pm * tstep + (size_t)cur.k0 * kstep; const char* cB = (const char*)g.Bt + (size_t)cur.pn * tstep + (size_t)cur.k0 * kstep;
    S.a_ready(cur);
    if constexpr (SP2) {
        PG8_STAGE(PG8_SB(0, 0), cB, voffB); PG8_STAGE(PG8_SB(0, 1), cB + hstep, voffB); PG8_STAGE(PG8_SA(0, 0), cA, voffA); PG8_STAGE(PG8_SA(0, 1), cA + hstep, voffA);
        if (wr == 1) PG8_BAR;
        PG8_WAIT_V(2); PG8_BAR;
        PG8_STAGE(PG8_SB(1, 0), cB + kstep, voffB); PG8_STAGE(PG8_SA(1, 0), cA + kstep, voffA); PG8_STAGE(PG8_SB(1, 1), cB + hstep + kstep, voffB);
        PG8_WAIT_V(6); PG8_BAR;
    } else {
        PG8_STAGE(PG8_SB(0, 0), cB, voffB); PG8_STAGE(PG8_SA(0, 0), cA, voffA); PG8_STAGE(PG8_SB(0, 1), cB + hstep, voffB); PG8_STAGE(PG8_SA(0, 1), cA + hstep, voffA);
        if (wr == 1) PG8_BAR;
        PG8_WAIT_V(4); PG8_BAR;
        PG8_STAGE(PG8_SB(1, 0), cB + kstep, voffB); PG8_STAGE(PG8_SA(1, 0), cA + kstep, voffA); PG8_STAGE(PG8_SB(1, 1), cB + hstep + kstep, voffB);
        PG8_WAIT_V(6); PG8_BAR;
    }
    for (;;) {
        const bool has_next = S.next(ui + 1, nxt);
        const char* nA = has_next ? (const char*)g.A + (size_t)nxt.pm * tstep + (size_t)nxt.k0 * kstep : cA; const char* nB = has_next ? (const char*)g.Bt + (size_t)nxt.pn * tstep + (size_t)nxt.k0 * kstep : cB;
        const int nt = cur.nt;
        for (int t = 0; t < nt; t += 2) {
            const bool last = (t == nt - 2);
            const char* a1 = cA + (size_t)(t + 1) * kstep;
            const char* a2 = last ? nA : cA + (size_t)(t + 2) * kstep; const char* b2 = last ? nB : cB + (size_t)(t + 2) * kstep;
            const char* a3 = a2 + kstep; const char* b3 = b2 + kstep;
            if (last && has_next) S.a_ready(nxt);
            if constexpr (SP2) {
            PG8_LDB(B0, 0, 0); PG8_LDB(B1, 0, 1); PG8_SCHED; PG8_LDA(At, 0, 0); PG8_STAGE(PG8_SA(1, 1), a1 + hstep, voffA);
            PG8_WAIT_V(8); PG8_WAIT_L(0); PG8_BAR; PG8_MMA(0, 0, At, B0); PG8_MMA(0, 1, At, B1); PG8_BAR; PG8_SCHED;
            PG8_LDA(At, 0, 1); PG8_STAGE(PG8_SB(0, 0), b2, voffB); PG8_STAGE(PG8_SB(0, 1), b2 + hstep, voffB); PG8_STAGE(PG8_SA(0, 0), a2, voffA);
            PG8_WAIT_V(8); PG8_WAIT_L(0); PG8_BAR; PG8_MMA(1, 0, At, B0); PG8_MMA(1, 1, At, B1); PG8_BAR; PG8_SCHED;
            PG8_LDB(B0, 1, 0); PG8_LDB(B1, 1, 1); PG8_SCHED; PG8_LDA(At, 1, 0); PG8_STAGE(PG8_SA(0, 1), a2 + hstep, voffA);
            PG8_WAIT_V(8); PG8_WAIT_L(0); PG8_BAR; PG8_MMA(0, 0, At, B0); PG8_MMA(0, 1, At, B1); PG8_BAR; PG8_SCHED;
            PG8_LDA(At, 1, 1); PG8_STAGE(PG8_SB(1, 0), b3, voffB); PG8_STAGE(PG8_SB(1, 1), b3 + hstep, voffB); PG8_STAGE(PG8_SA(1, 0), a3, voffA);
            PG8_WAIT_V(8); PG8_WAIT_L(0); PG8_BAR; PG8_MMA(1, 0, At, B0); PG8_MMA(1, 1, At, B1); PG8_BAR; PG8_SCHED;
            } else {
            PG8_LDB(B0, 0, 0); PG8_SCHED; PG8_LDA(At, 0, 0); PG8_STAGE(PG8_SA(1, 1), a1 + hstep, voffA);
            PG8_WAIT_L(8); PG8_BAR; PG8_WAIT_L(0); PG8_MMA(0, 0, At, B0); PG8_BAR; PG8_SCHED;
            PG8_LDB(B1, 0, 1); PG8_STAGE(PG8_SB(0, 0), b2, voffB);
            PG8_BAR; PG8_WAIT_L(0); PG8_MMA(0, 1, At, B1); PG8_BAR;
            PG8_LDA(At, 0, 1); PG8_STAGE(PG8_SA(0, 0), a2, voffA);
            PG8_BAR; PG8_WAIT_L(0); PG8_MMA(1, 0, At, B0); PG8_BAR; PG8_SCHED;
            PG8_STAGE(PG8_SB(0, 1), b2 + hstep, voffB);
            PG8_WAIT_V(6); PG8_BAR; PG8_MMA(1, 1, At, B1); PG8_BAR;
            PG8_LDB(B0, 1, 0); PG8_SCHED; PG8_LDA(At, 1, 0); PG8_STAGE(PG8_SA(0, 1), a2 + hstep, voffA);
            PG8_WAIT_L(8); PG8_BAR; PG8_WAIT_L(0); PG8_MMA(0, 0, At, B0); PG8_BAR; PG8_SCHED;
            PG8_LDB(B1, 1, 1); PG8_STAGE(PG8_SB(1, 0), b3, voffB);
            PG8_BAR; PG8_WAIT_L(0); PG8_MMA(0, 1, At, B1); PG8_BAR;
            PG8_LDA(At, 1, 1); PG8_STAGE(PG8_SA(1, 0), a3, voffA);
            PG8_BAR; PG8_WAIT_L(0); PG8_MMA(1, 0, At, B0); PG8_BAR; PG8_SCHED;
            PG8_STAGE(PG8_SB(1, 1), b3 + hstep, voffB);
            PG8_WAIT_V(6); PG8_BAR; PG8_MMA(1, 1, At, B1); PG8_BAR;
            }
        }
        if constexpr (ALIGN_EPI) { if (wr == 0) PG8_BAR; }
        if constexpr (!Epi::AFTER_DRAIN) { E(acc, cur, wr, wc, fr, fq); S.done(cur); }
        if (!has_next) break;
#pragma unroll
        for (int a = 0; a < 2; ++a)
#pragma unroll
            for (int b = 0; b < 2; ++b)
#pragma unroll
                for (int m = 0; m < 4; ++m)
#pragma unroll
                    for (int n = 0; n < 2; ++n) acc[a][b][m][n] = (f32x4){0.f, 0.f, 0.f, 0.f};
        cur = nxt; cA = nA; cB = nB; ++ui;
        if constexpr (ALIGN_EPI) { if (wr == 1) PG8_BAR; }
    }
    PG8_WAIT_V(0);
    if constexpr (!ALIGN_EPI) { if (wr == 0) PG8_BAR; }
    PG8_BAR;
    if constexpr (Epi::AFTER_DRAIN) { E.fused(acc, cur, wr, wc, fr, fq, lds, wid, lane); S.done(cur); }
#undef PG8_SA
#undef PG8_SB
#undef PG8_STAGE
#undef PG8_LDA
#undef PG8_LDB
#undef PG8_MMA
#undef PG8_WAIT_V
#undef PG8_WAIT_L
#undef PG8_BAR
#undef PG8_SCHED
}
}

#ifndef REP_P0
#define REP_P0 1
#endif
#ifndef REP_G1
#define REP_G1 1
#endif
#ifndef REP_M1
#define REP_M1 1
#endif
#ifndef REP_M3
#define REP_M3 1
#endif
#ifndef REP_UP
#define REP_UP 1
#endif
#ifndef REP_ACT
#define REP_ACT 1
#endif
#ifndef REP_NRM
#define REP_NRM 1
#endif
#ifndef DEFER_STATE
#define DEFER_STATE 0
#endif
#ifndef REP_M1A
#define REP_M1A 1
#endif
#ifndef REP_M1S
#define REP_M1S 1
#endif
#ifndef REP_M1C
#define REP_M1C 1
#endif
#ifndef NT_EPI
#define NT_EPI 0
#endif
#if NT_EPI
#define EPI_ST(p, v) __builtin_nontemporal_store((v), (p))
#else
#define EPI_ST(p, v) (*(p) = (v))
#endif
#ifndef RUN_FIX
#define RUN_FIX 0
#endif
#ifndef P0_WG
#define P0_WG 1
#endif
using pg8::bf16_t; using pg8::bf16x8; using pg8::f32x4; using pg8::u32x4; using pg8::cvt_pk_bf16;
typedef unsigned u32x2 __attribute__((ext_vector_type(2)));
#define LAS __attribute__((address_space(3)))
constexpr int DM = 2048, SEQ = 2048, NBATCH = 4, MP = 8192, NS = 128, MREAL = 8320, MPAD = 8448;
constexpr int CONVD = 1024, NH = 4, DK = 128, DV = 256, QKD = 512, RANK = 16, DFF = 5632;
constexpr int INC = 6160, INP = 6400, UPN = 11264, PRW = 4096;
constexpr int NCH = 32, NTHR = 512;
constexpr float EPS = 1e-6f;
constexpr size_t O_YP = 0, O_YS = 16777216, O_CP = 17039360, O_GP = 17055744, O_FP = 18104320, O_CS = 18194432, O_GS = 18718720, O_FS = 52273152, O_TOTAL = 55156736;
constexpr size_t SZ_WIN = (size_t)INP * DM * 2, SZ_WOUT = (size_t)DM * DM * 2, SZ_WUP = (size_t)UPN * DM * 2, SZ_WDN = (size_t)DM * DFF * 2;
constexpr size_t WS_WIN = 0, WS_WOUT = WS_WIN + 2 * SZ_WIN, WS_WUP = WS_WOUT + 2 * SZ_WOUT, WS_WDN = WS_WUP + 2 * SZ_WUP;
constexpr size_t WS_XN = WS_WDN + 2 * SZ_WDN, WS_XR = WS_XN + (size_t)MPAD * DM * 2, WS_R = WS_XR + (size_t)MPAD * DM * 4;
constexpr size_t WS_PR = WS_R, WS_UC = WS_PR + (size_t)MPAD * PRW * 2, WS_GLR = WS_UC + (size_t)MPAD * CONVD * 4, WS_Y = WS_GLR + (size_t)MPAD * RANK * 4;
constexpr size_t WS_SU = WS_Y + (size_t)MPAD * DM * 2, WS_EB = WS_SU + (size_t)16 * NCH * DK * DV * 4, WS_QT = WS_EB + (size_t)16 * NCH * DK * 4, WS_AM = WS_QT + (size_t)MP * QKD * 2;
constexpr size_t WS_MIX_END = WS_AM + (size_t)512 * 4096 * 2;
constexpr size_t WS_H = WS_R, WS_FFN_END = WS_H + (size_t)MPAD * DFF * 2;
constexpr size_t WS_REND = WS_FFN_END > WS_MIX_END ? WS_FFN_END : WS_MIX_END;
constexpr int PRSW = 6400, NSP1 = 4;
constexpr size_t WS_PRS = WS_REND, WS_GLRP = WS_PRS + (size_t)8 * NS * PRSW * 4, WS_XSP = WS_GLRP + (size_t)8 * MPAD * RANK * 4, WS_END = WS_XSP + (size_t)11 * NS * DM * 4;
constexpr size_t WS_BAR = WS_END;
constexpr size_t WS_SS = WS_BAR + 16384, WS_SSP = WS_SS + (size_t)4 * MPAD * 4, WS_TAIL = WS_SSP + (size_t)MP * 32 * 4, WS_HEAD = WS_TAIL + (size_t)132 * 2 * DFF * 4, WS_TOTAL = WS_HEAD + (size_t)132 * 4 * DFF * 4;
constexpr int LDS_BYTES = 147456, LDS_BARST = LDS_BYTES - 64, LDS_HALO = 131072 + 2048;

__device__ __forceinline__ float bf_lo(unsigned w) { return __uint_as_float(w << 16); }
__device__ __forceinline__ float bf_hi(unsigned w) { return __uint_as_float(w & 0xffff0000u); }
__device__ __forceinline__ float bf1(bf16_t h) { return __uint_as_float((unsigned)h << 16); }
__device__ __forceinline__ bf16_t f2bf(float f) { return (bf16_t)(cvt_pk_bf16(f, 0.f) & 0xffffu); }
__device__ __forceinline__ float silu_f(float x) { return x * __builtin_amdgcn_rcpf(1.f + __expf(-x)); }
__device__ __forceinline__ float logsig_f(float z) { return fminf(z, 0.f) - __logf(1.f + __expf(-fabsf(z))); }
__device__ __forceinline__ float wave_sum(float v) {
#pragma unroll
    for (int o = 1; o < 64; o <<= 1) v += __shfl_xor(v, o);
    return v;
}
#define LDS_WAIT() asm volatile("s_waitcnt lgkmcnt(0)" ::: "memory")

__device__ __forceinline__ void tr_item(const float* W, int ldw, int ncols_valid, int K, bf16_t* WT, int dst_row0, int src_col0, bool perm, int kb, LAS float* scr, int lane, const float* gk = nullptr) {
    const int k0 = 64 * kb; const int c = src_col0 + (lane & 31); const bool ok = c < ncols_valid;
    float tv[32];
#pragma unroll
    for (int i = 0; i < 32; ++i) { const int kk = 2 * i + (lane >> 5); tv[i] = ok ? W[(size_t)(k0 + kk) * ldw + c] : 0.f; }
#pragma unroll
    for (int i = 0; i < 32; ++i) { const int kk = 2 * i + (lane >> 5); scr[kk * 33 + (lane & 31)] = gk ? tv[i] * gk[k0 + kk] : tv[i]; }
    LDS_WAIT(); asm volatile("" ::: "memory");
    const int c8 = lane & 7;
#pragma unroll
    for (int j = 0; j < 4; ++j) { const int n = (lane >> 3) + 8 * j; const int sc = perm ? pg8::perm32(n) : n; const LAS float* s = scr + (8 * c8) * 33 + sc;
        u32x4 o; o.x = cvt_pk_bf16(s[0 * 33], s[1 * 33]); o.y = cvt_pk_bf16(s[2 * 33], s[3 * 33]); o.z = cvt_pk_bf16(s[4 * 33], s[5 * 33]); o.w = cvt_pk_bf16(s[6 * 33], s[7 * 33]);
        *(u32x4*)(WT + (size_t)(dst_row0 + n) * K + k0 + 8 * c8) = o; }
    LDS_WAIT(); asm volatile("" ::: "memory");
}
__device__ __forceinline__ void win_map(int g, int& src, int& nvalid, bool& perm) {
    const int tile = g >> 3, gi = g & 7; nvalid = INC;
    if (tile < 8) { perm = false; src = (gi < 4) ? (1024 + 128 * tile + 32 * gi) : (2048 + 128 * tile + 32 * (gi - 4)); }
    else if (tile < 12) { perm = true; src = 256 * (tile - 8) + 32 * gi; }
    else if (tile < 24) { perm = true; src = 3072 + 256 * (tile - 12) + 32 * gi; }
    else { perm = false; src = 6144; if (gi != 0) nvalid = 0; }
}
struct P0Desc { const float* src; size_t ldw; const float* gk; bf16_t* dst; int K; bool ok, perm; };
constexpr int P0_I_IN = 25 * 32, P0_I_OUT = 8 * 32, P0_I_UP = 44 * 32, P0_I_DN = 8 * 88, P0_I_L = P0_I_IN + P0_I_OUT + P0_I_UP + P0_I_DN;
struct P0Src { const float *w_in, *w_out, *w_up, *w_down, *g_mix, *g_ffn; bf16_t *WT_IN, *WT_OUT, *WT_UP, *WT_DN; };
__device__ __forceinline__ bool p0_decode(int it, const P0Src& t, int wid, int lane, P0Desc& d) {
    if (it >= 2 * P0_I_L) return false;
    const int l = it / P0_I_L; int rr = it - l * P0_I_L; const float* W; int ldw, nv, K, blk, kb, dg; bf16_t* WT; bool perm; const float* gk = nullptr;
    if (rr < P0_I_IN) { blk = rr >> 5; kb = rr & 31; const int sg = blk * 8 + wid; W = t.w_in + (size_t)l * DM * INC; ldw = INC; nv = INC; K = DM; WT = t.WT_IN + (size_t)l * INP * DM; gk = t.g_mix + (size_t)l * DM;
        if (sg < 32) { dg = 64 + sg; perm = true; } else if (sg < 64) { const int q = sg - 32; dg = (q >> 2) * 8 + (q & 3); perm = true; } else if (sg < 96) { const int q = sg - 64; dg = (q >> 2) * 8 + 4 + (q & 3); perm = true; }
        else { dg = sg; perm = sg < 192; } }
    else if ((rr -= P0_I_IN) < P0_I_OUT) { blk = rr >> 5; kb = rr & 31; dg = blk * 8 + wid; perm = true; W = t.w_out + (size_t)l * DM * DM; ldw = DM; nv = DM; K = DM; WT = t.WT_OUT + (size_t)l * DM * DM; }
    else if ((rr -= P0_I_OUT) < P0_I_UP) { blk = rr >> 5; kb = rr & 31; const int sg = blk * 8 + wid; perm = true; W = t.w_up + (size_t)l * DM * UPN; ldw = UPN; nv = UPN; K = DM; WT = t.WT_UP + (size_t)l * UPN * DM; gk = t.g_ffn + (size_t)l * DM;
        if (sg < 176) dg = (sg >> 2) * 8 + (sg & 3); else { const int q = sg - 176; dg = (q >> 2) * 8 + 4 + (q & 3); } }
    else { rr -= P0_I_UP; blk = rr / 88; kb = rr - blk * 88; dg = blk * 8 + wid; perm = true; W = t.w_down + (size_t)l * DFF * DM; ldw = DM; nv = DM; K = DFF; WT = t.WT_DN + (size_t)l * DM * DFF; }
    const int k0 = 64 * kb, c = blk * 256 + 4 * lane;
    d.ok = c < nv; d.src = W + (size_t)(k0 + wid * 8) * ldw + c; d.ldw = (size_t)ldw; d.gk = gk ? gk + k0 + wid * 8 : nullptr; d.dst = WT + (size_t)(dg * 32) * K + k0; d.K = K; d.perm = perm; return true;
}
__device__ __forceinline__ void p0_load(const P0Desc& d, f32x4 (&tv)[8]) {
#pragma unroll
    for (int i = 0; i < 8; ++i) tv[i] = d.ok ? *(const f32x4*)(d.src + (size_t)i * d.ldw) : (f32x4){0.f, 0.f, 0.f, 0.f};
}
__device__ __forceinline__ void p0_to_lds(const P0Desc& d, const f32x4 (&tv)[8], LAS float* T, int wid, int lane) {
#pragma unroll
    for (int i = 0; i < 8; ++i) { const float g = d.gk ? d.gk[i] : 1.f; LAS float* tp = T + (wid * 8 + i) * 257 + 4 * lane; tp[0] = tv[i].x * g; tp[1] = tv[i].y * g; tp[2] = tv[i].z * g; tp[3] = tv[i].w * g; }
}
__device__ __forceinline__ void p0_out(const P0Desc& d, const LAS float* T, int wid, int lane) {
    const int c8 = lane & 7;
#pragma unroll
    for (int j = 0; j < 4; ++j) { const int n = (lane >> 3) + 8 * j; const int sc = d.perm ? pg8::perm32(n) : n; const LAS float* sp = T + (8 * c8) * 257 + 32 * wid + sc;
        u32x4 o; o.x = cvt_pk_bf16(sp[0 * 257], sp[1 * 257]); o.y = cvt_pk_bf16(sp[2 * 257], sp[3 * 257]); o.z = cvt_pk_bf16(sp[4 * 257], sp[5 * 257]); o.w = cvt_pk_bf16(sp[6 * 257], sp[7 * 257]);
        *(u32x4*)(d.dst + (size_t)n * d.K + 8 * c8) = o; }
}
__device__ __forceinline__ void rms_row_bf16(const float* xrow, const float* g, bf16_t* orow, int lane) {
    const f32x4* xr = (const f32x4*)xrow + lane; f32x4 v[8]; float s = 0.f;
#pragma unroll
    for (int j = 0; j < 8; ++j) { v[j] = xr[64 * j]; s += (v[j].x * v[j].x + v[j].y * v[j].y) + (v[j].z * v[j].z + v[j].w * v[j].w); }
    const float rstd = rsqrtf(wave_sum(s) * (1.f / DM) + EPS);
    const f32x4* gr = (const f32x4*)g + lane; u32x2* o8 = (u32x2*)orow + lane;
#pragma unroll
    for (int j = 0; j < 8; ++j) { const f32x4 gg = gr[64 * j]; u32x2 w; w.x = cvt_pk_bf16(v[j].x * rstd * gg.x, v[j].y * rstd * gg.y); w.y = cvt_pk_bf16(v[j].z * rstd * gg.z, v[j].w * rstd * gg.w); o8[64 * j] = w; }
}
__device__ __forceinline__ void row_bf16_ss(const float* xrow, bf16_t* orow, float* ss, int lane) {
    const f32x4* xr = (const f32x4*)xrow + lane; f32x4 v[8]; float s = 0.f;
#pragma unroll
    for (int j = 0; j < 8; ++j) { v[j] = xr[64 * j]; s += (v[j].x * v[j].x + v[j].y * v[j].y) + (v[j].z * v[j].z + v[j].w * v[j].w); }
    s = wave_sum(s); u32x2* o8 = (u32x2*)orow + lane;
#pragma unroll
    for (int j = 0; j < 8; ++j) { u32x2 w; w.x = cvt_pk_bf16(v[j].x, v[j].y); w.y = cvt_pk_bf16(v[j].z, v[j].w); o8[64 * j] = w; }
    if (lane == 0) *ss = s;
}
__device__ __forceinline__ void rms_row2_bf16(const float* xa, const float* xb, const float* g, bf16_t* oa, bf16_t* ob, int lane) {
    const f32x4* ra = (const f32x4*)xa + lane; const f32x4* rb = (const f32x4*)xb + lane; f32x4 va[8], vb[8]; float sa = 0.f, sb = 0.f;
#pragma unroll
    for (int j = 0; j < 8; ++j) { va[j] = ra[64 * j]; vb[j] = rb[64 * j]; }
#pragma unroll
    for (int j = 0; j < 8; ++j) { sa += (va[j].x * va[j].x + va[j].y * va[j].y) + (va[j].z * va[j].z + va[j].w * va[j].w); sb += (vb[j].x * vb[j].x + vb[j].y * vb[j].y) + (vb[j].z * vb[j].z + vb[j].w * vb[j].w); }
    const float rsa = rsqrtf(wave_sum(sa) * (1.f / DM) + EPS), rsb = rsqrtf(wave_sum(sb) * (1.f / DM) + EPS);
    const f32x4* gr = (const f32x4*)g + lane; u32x2* pa = (u32x2*)oa + lane; u32x2* pb = (u32x2*)ob + lane;
#pragma unroll
    for (int j = 0; j < 8; ++j) { const f32x4 gg = gr[64 * j]; u32x2 w;
        w.x = cvt_pk_bf16(va[j].x * rsa * gg.x, va[j].y * rsa * gg.y); w.y = cvt_pk_bf16(va[j].z * rsa * gg.z, va[j].w * rsa * gg.w); pa[64 * j] = w;
        w.x = cvt_pk_bf16(vb[j].x * rsb * gg.x, vb[j].y * rsb * gg.y); w.y = cvt_pk_bf16(vb[j].z * rsb * gg.z, vb[j].w * rsb * gg.w); pb[64 * j] = w; }
}
__device__ __forceinline__ void rms_row_f32(const float* xrow, const float* g, float* orow, int lane) {
    const f32x4* xr = (const f32x4*)xrow + lane; f32x4 v[8]; float s = 0.f;
#pragma unroll
    for (int j = 0; j < 8; ++j) { v[j] = xr[64 * j]; s += (v[j].x * v[j].x + v[j].y * v[j].y) + (v[j].z * v[j].z + v[j].w * v[j].w); }
    const float rstd = rsqrtf(wave_sum(s) * (1.f / DM) + EPS);
    const f32x4* gr = (const f32x4*)g + lane; f32x4* o = (f32x4*)orow + lane;
#pragma unroll
    for (int j = 0; j < 8; ++j) { const f32x4 gg = gr[64 * j]; o[64 * j] = v[j] * rstd * gg; }
}

struct EpiIn {
    static constexpr bool PERM = false, AFTER_DRAIN = false;
    bf16_t* PR; float* UC; float* GLRP; float* PRS; const float* SS; float* conv_p;
    __device__ __forceinline__ void operator()(const f32x4 (&acc)[2][2][4][2], const pg8::Unit& u, int wr, int wc, int fr, int fq) const {
        asm volatile("" : "+v"(fr), "+v"(fq), "+s"(wr), "+s"(wc));
        const int row0 = u.pm * 256 + wr * 64 + fr;
        float rs[2][4];
#pragma unroll
        for (int ai = 0; ai < 2; ++ai)
#pragma unroll
            for (int m = 0; m < 4; ++m) rs[ai][m] = rsqrtf(SS[row0 + ai * 128 + m * 16] * (1.f / DM) + EPS);
        if (u.pn == 24) {
            if (wc == 0) {
#pragma unroll
                for (int ai = 0; ai < 2; ++ai)
#pragma unroll
                    for (int m = 0; m < 4; ++m) *(f32x4*)(GLRP + ((size_t)u.sp * MPAD + row0 + ai * 128 + m * 16) * RANK + 4 * fq) = acc[ai][0][m][0] * rs[ai][m];
            }
        } else if (u.sp >= 0) {
            float* rp0 = PRS + ((size_t)u.sp * NS + wr * 64 + fr) * PRSW;
            if (u.pn < 8) {
#pragma unroll
                for (int m = 0; m < 4; ++m) { float* rp = rp0 + (size_t)(m * 16) * PRSW + 1024 + u.pn * 128 + wc * 32 + 8 * fq;
#pragma unroll
                    for (int bj = 0; bj < 2; ++bj)
#pragma unroll
                        for (int n = 0; n < 2; ++n) *(f32x4*)(rp + bj * 1024 + 4 * n) = acc[0][bj][m][n] * rs[0][m]; }
            } else { const int cb = (u.pn < 12 ? 256 * (u.pn - 8) : 3072 + 256 * (u.pn - 12)) + wc * 32 + 8 * fq;
#pragma unroll
                for (int m = 0; m < 4; ++m) { float* rp = rp0 + (size_t)(m * 16) * PRSW + cb;
#pragma unroll
                    for (int bj = 0; bj < 2; ++bj)
#pragma unroll
                        for (int n = 0; n < 2; ++n) *(f32x4*)(rp + bj * 128 + 4 * n) = acc[0][bj][m][n] * rs[0][m]; }
            }
        } else if (u.pn < 8) {
#pragma unroll
            for (int ai = 0; ai < 2; ++ai)
#pragma unroll
                for (int m = 0; m < 4; ++m) { const int row = row0 + ai * 128 + m * 16, cc = u.pn * 128 + wc * 32 + 8 * fq; bf16_t* rp = (bf16_t*)UC + (size_t)row * CONVD + cc; const float r2 = rs[ai][m] * rs[ai][m]; const int p = row & (SEQ - 1);
                    const f32x4 u0 = acc[ai][0][m][0] * acc[ai][1][m][0] * r2, u1 = acc[ai][0][m][1] * acc[ai][1][m][1] * r2; u32x4 w;
                    w.x = cvt_pk_bf16(u0.x, u0.y); w.y = cvt_pk_bf16(u0.z, u0.w); w.z = cvt_pk_bf16(u1.x, u1.y); w.w = cvt_pk_bf16(u1.z, u1.w); EPI_ST((u32x4*)rp, w);
                    if (p >= SEQ - 2) { float* sp = conv_p + ((size_t)(row >> 11) * 2 + (p - (SEQ - 2))) * CONVD + cc; *(f32x4*)sp = u0; *(f32x4*)(sp + 4) = u1; } }
        } else {
#pragma unroll
            for (int ai = 0; ai < 2; ++ai)
#pragma unroll
                for (int m = 0; m < 4; ++m) { bf16_t* rp = PR + (size_t)(row0 + ai * 128 + m * 16) * PRW + (u.pn - 8) * 256 + wc * 32 + 8 * fq; const float r1 = rs[ai][m];
#pragma unroll
                    for (int bj = 0; bj < 2; ++bj) { const f32x4 v0 = acc[ai][bj][m][0] * r1, v1 = acc[ai][bj][m][1] * r1; u32x4 w;
                        w.x = cvt_pk_bf16(v0[0], v0[1]); w.y = cvt_pk_bf16(v0[2], v0[3]); w.z = cvt_pk_bf16(v1[0], v1[1]); w.w = cvt_pk_bf16(v1[2], v1[3]);
                        EPI_ST((u32x4*)(rp + bj * 128), w); } }
        }
    }
};
template <int N> __device__ __forceinline__ float ror16(float v) { return __int_as_float(__builtin_amdgcn_update_dpp(0, __float_as_int(v), 0x120 + N, 0xF, 0xF, false)); }
struct EpiUp {
    static constexpr bool PERM = false, AFTER_DRAIN = false;
    bf16_t* H; const float* cw; const float* cb; float* TAIL; float* HEAD; const float* st_in; float* ffn_p; float* ffn_s; LAS float* halo; const float* SS;
    __device__ __forceinline__ void operator()(const f32x4 (&acc)[2][2][4][2], const pg8::Unit& u, int wr, int wc, int fr, int fq) const {
        asm volatile("" : "+v"(fr), "+v"(fq), "+s"(wr), "+s"(wc));
        const int col = u.pn * 128 + wc * 32 + 8 * fq; const int lc = wc * 32 + 8 * fq;
        if (u.pm == 32) {
            if (!RUN_FIX) __builtin_amdgcn_s_barrier();
#pragma unroll
            for (int n = 0; n < 2; ++n) { const int cn = col + 4 * n;
                const f32x4 w0 = *(const f32x4*)(cw + cn), w1 = *(const f32x4*)(cw + DFF + cn), w2 = *(const f32x4*)(cw + 2 * DFF + cn), bb = *(const f32x4*)(cb + cn);
#pragma unroll
                for (int m = 0; m < 4; ++m) { const int s = wr * 64 + m * 16 + fr; const float* sp = st_in + (size_t)s * 2 * DFF + cn; float* op = ffn_s + (size_t)s * 2 * DFF + cn;
                    const float r1 = rsqrtf(SS[MP + s] * (1.f / DM) + EPS);
                    const f32x4 s0 = *(const f32x4*)sp, s1 = *(const f32x4*)(sp + DFF), uu = acc[0][0][m][n] * r1, vv = acc[0][1][m][n] * r1;
                    *(f32x4*)op = s1; *(f32x4*)(op + DFF) = uu;
                    const f32x4 cu = s0 * w0 + s1 * w1 + uu * w2 + bb; u32x2 hw;
                    hw.x = cvt_pk_bf16(silu_f(cu[0]) * vv[0], silu_f(cu[1]) * vv[1]); hw.y = cvt_pk_bf16(silu_f(cu[2]) * vv[2], silu_f(cu[3]) * vv[3]);
                    *(u32x2*)(H + (size_t)(MP + s) * DFF + cn) = hw; *(u32x2*)(H + (size_t)(MP + 128 + s) * DFF + cn) = (u32x2){0u, 0u}; }
                asm volatile("" ::: "memory"); }
            return;
        }
        const int row0 = u.pm * 256 + wr * 64 + fr;
        float rs[2][4];
#pragma unroll
        for (int ai = 0; ai < 2; ++ai)
#pragma unroll
            for (int m = 0; m < 4; ++m) rs[ai][m] = rsqrtf(SS[row0 + ai * 128 + m * 16] * (1.f / DM) + EPS);
        if (!RUN_FIX) {
        if (fr >= 14) {
#pragma unroll
            for (int ai = 0; ai < 2; ++ai)
#pragma unroll
                for (int n = 0; n < 2; ++n) *(LAS f32x4*)(halo + ((2 * ai + wr) * 2 + (fr - 14)) * 128 + lc + 4 * n) = acc[ai][0][3][n] * rs[ai][3];
        }
        asm volatile("s_waitcnt lgkmcnt(0)" ::: "memory"); __builtin_amdgcn_s_barrier(); asm volatile("" ::: "memory");
        }
        u32x2 hkeep[2][4];
#pragma unroll
        for (int n = 0; n < 2; ++n) { const int cn = col + 4 * n;
            const f32x4 w0 = *(const f32x4*)(cw + cn), w1 = *(const f32x4*)(cw + DFF + cn), w2 = *(const f32x4*)(cw + 2 * DFF + cn), bb = *(const f32x4*)(cb + cn);
#pragma unroll
            for (int ai = 0; ai < 2; ++ai) {
                const int rho = 2 * ai + wr; const f32x4 z = {0.f, 0.f, 0.f, 0.f};
                const f32x4 h0 = (!RUN_FIX && rho > 0) ? *(const LAS f32x4*)(halo + ((rho - 1) * 2 + 0) * 128 + lc + 4 * n) : z, h1 = (!RUN_FIX && rho > 0) ? *(const LAS f32x4*)(halo + ((rho - 1) * 2 + 1) * 128 + lc + 4 * n) : z;
                f32x4 pu = {0.f, 0.f, 0.f, 0.f};
#pragma unroll
                for (int m = 0; m < 4; ++m) { const f32x4 uu = acc[ai][0][m][n] * rs[ai][m], vv = acc[ai][1][m][n] * rs[ai][m]; f32x4 p1, p2;
#pragma unroll
                    for (int e = 0; e < 4; ++e) { const float c1 = ror16<1>(uu[e]), c2 = ror16<2>(uu[e]); float q1, q2;
                        if (m > 0) { q1 = ror16<1>(pu[e]); q2 = ror16<2>(pu[e]); }
                        else { q1 = h1[e]; q2 = fr == 1 ? h1[e] : h0[e]; }
                        p1[e] = fr >= 1 ? c1 : q1; p2[e] = fr >= 2 ? c2 : q2; }
                    const f32x4 cu = p2 * w0 + p1 * w1 + uu * w2 + bb; u32x2 hw;
                    hw.x = cvt_pk_bf16(silu_f(cu[0]) * vv[0], silu_f(cu[1]) * vv[1]); hw.y = cvt_pk_bf16(silu_f(cu[2]) * vv[2], silu_f(cu[3]) * vv[3]);
                    if (n == 0) hkeep[ai][m] = hw; else { u32x4 h4; h4.x = hkeep[ai][m].x; h4.y = hkeep[ai][m].y; h4.z = hw.x; h4.w = hw.y; EPI_ST((u32x4*)(H + (size_t)(row0 + ai * 128 + m * 16) * DFF + col), h4); } pu = uu;
                    if (RUN_FIX) { const int R = u.pm * 4 + rho;
                        if (m == 3 && fr >= 14) { *(f32x4*)(TAIL + ((size_t)R * 2 + (fr - 14)) * DFF + cn) = uu; if ((R & 31) == 31) *(f32x4*)(ffn_p + ((size_t)(R >> 5) * 2 + (fr - 14)) * DFF + cn) = uu; }
                        if (m == 0 && fr < 2) { float* hp = HEAD + ((size_t)R * 2 + fr) * 2 * DFF + cn; *(f32x4*)hp = uu; *(f32x4*)(hp + DFF) = vv; } } }
            }
            asm volatile("" ::: "memory"); }
        if (!RUN_FIX && wr == 1 && fr >= 14) {
            const f32x4 t0 = acc[1][0][3][0] * rs[1][3], t1 = acc[1][0][3][1] * rs[1][3];
            float* tp = TAIL + ((size_t)u.pm * 2 + (fr - 14)) * DFF + col; *(f32x4*)tp = t0; *(f32x4*)(tp + 4) = t1;
            if ((u.pm & 7) == 7) { float* sp = ffn_p + ((size_t)(u.pm >> 3) * 2 + (fr - 14)) * DFF + col; *(f32x4*)sp = t0; *(f32x4*)(sp + 4) = t1; }
        }
        if (!RUN_FIX && wr == 0 && fr < 2) {
            float* hp = HEAD + ((size_t)u.pm * 2 + fr) * 2 * DFF + col; const float r1 = rs[0][0]; *(f32x4*)hp = acc[0][0][0][0] * r1; *(f32x4*)(hp + 4) = acc[0][0][0][1] * r1; *(f32x4*)(hp + DFF) = acc[0][1][0][0] * r1; *(f32x4*)(hp + DFF + 4) = acc[0][1][0][1] * r1;
        }
    }
};
struct EpiRes {
    static constexpr bool PERM = false, AFTER_DRAIN = false;
    const float* baseP; float* out; float* XSP; bf16_t* XB; float* SS;
    __device__ __forceinline__ void operator()(const f32x4 (&acc)[2][2][4][2], const pg8::Unit& u, int wr, int wc, int fr, int fq) const {
        asm volatile("" : "+v"(fr), "+v"(fq), "+s"(wr), "+s"(wc));
        const int row0 = u.pm * 256 + wr * 64 + fr; const int col0 = u.pn * 256 + wc * 32 + 8 * fq;
        if (u.sp >= 0) {
#pragma unroll
            for (int m = 0; m < 4; ++m) { float* op = XSP + ((size_t)u.sp * NS + wr * 64 + m * 16 + fr) * DM + col0;
#pragma unroll
                for (int bj = 0; bj < 2; ++bj)
#pragma unroll
                    for (int n = 0; n < 2; ++n) *(f32x4*)(op + bj * 128 + 4 * n) = acc[0][bj][m][n]; }
            return;
        }
#pragma unroll
        for (int ai = 0; ai < 2; ++ai)
#pragma unroll
            for (int m = 0; m < 4; ++m) { const int row = row0 + ai * 128 + m * 16;
                { bf16_t* xb = XB + (size_t)row * DM + col0; float ss = 0.f;
#pragma unroll
                    for (int bj = 0; bj < 2; ++bj) { f32x4 b0, b1;
                        if (baseP) { const float* bp = baseP + (size_t)row * DM + col0 + bj * 128; b0 = *(const f32x4*)bp; b1 = *(const f32x4*)(bp + 4); }
                        else { const u32x4 bw = *(const u32x4*)(xb + bj * 128); b0 = (f32x4){bf_lo(bw.x), bf_hi(bw.x), bf_lo(bw.y), bf_hi(bw.y)}; b1 = (f32x4){bf_lo(bw.z), bf_hi(bw.z), bf_lo(bw.w), bf_hi(bw.w)}; }
                        const f32x4 v0 = b0 + acc[ai][bj][m][0], v1 = b1 + acc[ai][bj][m][1];
                        ss += ((v0.x * v0.x + v0.y * v0.y) + (v0.z * v0.z + v0.w * v0.w)) + ((v1.x * v1.x + v1.y * v1.y) + (v1.z * v1.z + v1.w * v1.w));
                        u32x4 w; w.x = cvt_pk_bf16(v0.x, v0.y); w.y = cvt_pk_bf16(v0.z, v0.w); w.z = cvt_pk_bf16(v1.x, v1.y); w.w = cvt_pk_bf16(v1.z, v1.w); EPI_ST((u32x4*)(xb + bj * 128), w); }
                    if (SS) { ss += __shfl_xor(ss, 16); ss += __shfl_xor(ss, 32); if (fq == 0) SS[(size_t)row * 32 + u.pn * 4 + wc] = ss; } }
                asm volatile("" ::: "memory"); }
    }
};

#define MFMA16(x, y, c) __builtin_amdgcn_mfma_f32_16x16x32_bf16((x), (y), (c), 0, 0, 0)
typedef short s16x4 __attribute__((ext_vector_type(4)));
template <int RS> __device__ __forceinline__ bf16x8 tr_frag(const LAS bf16_t* T, int c, int ks, int lane) {
#ifdef TR_GATHER
    const int g = lane >> 4; const LAS bf16_t* a0 = T + (32 * ks + 8 * g) * RS + 16 * c + (lane & 15); bf16x8 o;
#pragma unroll
    for (int j = 0; j < 8; ++j) o[j] = (short)a0[j * RS];
    return o;
#else
    const int g = lane >> 4, qq = (lane & 15) >> 2, p = lane & 3; const LAS bf16_t* a0 = T + (32 * ks + 8 * g + qq) * RS + 16 * c + 4 * p;
    unsigned addr = (unsigned)(size_t)a0; asm volatile("" : "+v"(addr));
    const LAS bf16_t* a1 = (const LAS bf16_t*)(size_t)addr;
    s16x4 t0 = __builtin_amdgcn_ds_read_tr16_b64_v4i16((LAS s16x4*)a1), t1 = __builtin_amdgcn_ds_read_tr16_b64_v4i16((LAS s16x4*)(a1 + 4 * RS));
    asm volatile("" : "+v"(t0), "+v"(t1) : "v"(addr));
    return __builtin_shufflevector(t0, t1, 0, 1, 2, 3, 4, 5, 6, 7);
#endif
}
__device__ __forceinline__ void stage_v(LAS bf16_t* Vn, const bf16_t* PR, int tok0, int h, int tid) {
#pragma unroll
    for (int i = 0; i < 4; ++i) { const int id = tid + 512 * i, j = id >> 5, cc = id & 31; *(LAS u32x4*)(Vn + j * 272 + cc * 8) = *(const u32x4*)(PR + (size_t)(tok0 + j) * PRW + 2048 + h * DV + cc * 8); }
}
__device__ __forceinline__ void gla_passA(LAS unsigned char* lds, int uidx, const bf16_t* PR, const float* GLRP, const float* w2, const float* gb,
                                          bf16_t* SUB, float* EB, bf16_t* QT, bf16_t* AM, int tid, int wid, int lane) {
    const int b = uidx >> 7, c = (uidx >> 2) & 31, h = uidx & 3; const int tok0 = b * SEQ + c * 64; const int bh = b * 4 + h;
    LAS float* Bc = (LAS float*)lds;
    LAS float* bCs = Bc + 64 * 129;
    LAS bf16_t* Qs = (LAS bf16_t*)(lds + 33536);
    LAS bf16_t* Ks = Qs + 64 * 136;
    LAS bf16_t* Kh = Ks + 64 * 136;
    LAS bf16_t* Vn = Kh + 64 * 136;
    const int r = lane & 15, q = lane >> 4;
    const bf16_t* qp = PR + (size_t)(tok0 + (tid >> 3)) * PRW + 1024 + h * DK + (tid & 7) * 16;
    const u32x4 qa = *(const u32x4*)qp, qb = *(const u32x4*)(qp + 8), ka = *(const u32x4*)(qp + 512), kb = *(const u32x4*)(qp + 520);
    u32x4 vreg[4];
#pragma unroll
    for (int i = 0; i < 4; ++i) { const int id = tid + 512 * i; vreg[i] = *(const u32x4*)(PR + (size_t)(tok0 + (id >> 5)) * PRW + 2048 + h * DV + (id & 31) * 8); }
    LAS float* Gs = (LAS float*)(lds + 120576);
    LAS float* Tt = Gs + 64 * 16;
    if (tid < 256) { const int t = tid >> 2, r4 = (tid & 3) * 4; const float* gp = GLRP + (size_t)(tok0 + t) * RANK + r4; f32x4 g = *(const f32x4*)gp;
#pragma unroll
        for (int sp = 1; sp < NSP1; ++sp) g += *(const f32x4*)(gp + (size_t)sp * MPAD * RANK);
        *(LAS f32x4*)(Gs + t * 16 + r4) = g; }
    const int kcol = tid & 127, tg = tid >> 7;
    float wk[16];
#pragma unroll
    for (int rr = 0; rr < 16; ++rr) wk[rr] = w2[rr * QKD + h * DK + kcol];
    const float bias = gb[h * DK + kcol];
#pragma unroll
    for (int i = 0; i < 4; ++i) { const int id = tid + 512 * i; *(LAS u32x4*)(Vn + (id >> 5) * 272 + (id & 31) * 8) = vreg[i]; }
    __syncthreads();
    { float run = 0.f;
#pragma unroll 4
      for (int i = 0; i < 16; ++i) { const int t = 16 * tg + i; const LAS f32x4* gr = (const LAS f32x4*)(Gs + t * 16); const f32x4 a0 = gr[0], a1 = gr[1], a2 = gr[2], a3 = gr[3];
          float z = bias;
          z += a0.x * wk[0] + a0.y * wk[1] + a0.z * wk[2] + a0.w * wk[3]; z += a1.x * wk[4] + a1.y * wk[5] + a1.z * wk[6] + a1.w * wk[7];
          z += a2.x * wk[8] + a2.y * wk[9] + a2.z * wk[10] + a2.w * wk[11]; z += a3.x * wk[12] + a3.y * wk[13] + a3.z * wk[14] + a3.w * wk[15];
          run += logsig_f(z) * (1.f / 16.f); Bc[t * 129 + kcol] = run; }
      Tt[tg * 128 + kcol] = run; }
    __syncthreads();
    {
        const int j = tid >> 3, kr = (tid & 7) * 16, jg = j >> 4;
        const float scale = 0.08838834764831845f;
        u32x4 oq[2], ok[2], oh[2];
#pragma unroll
        for (int e4 = 0; e4 < 4; ++e4) {
            const f32x4 t0 = *(const LAS f32x4*)(Tt + 0 * 128 + kr + 4 * e4), t1 = *(const LAS f32x4*)(Tt + 1 * 128 + kr + 4 * e4), t2 = *(const LAS f32x4*)(Tt + 2 * 128 + kr + 4 * e4), t3 = *(const LAS f32x4*)(Tt + 3 * 128 + kr + 4 * e4);
            const f32x4 zz = {0.f, 0.f, 0.f, 0.f}; const f32x4 off = (jg > 0 ? t0 : zz) + (jg > 1 ? t1 : zz) + (jg > 2 ? t2 : zz), bc = (t0 + t1) + (t2 + t3);
#pragma unroll
            for (int eh = 0; eh < 2; ++eh) { const int e2 = 2 * e4 + eh; const unsigned qw = e2 < 4 ? qa[e2] : qb[e2 - 4], kw = e2 < 4 ? ka[e2] : kb[e2 - 4];
                const int k = kr + 2 * e2;
                const float b0 = Bc[j * 129 + k] + off[2 * eh], b1 = Bc[j * 129 + k + 1] + off[2 * eh + 1], c0 = bc[2 * eh], c1 = bc[2 * eh + 1];
                const float q0 = bf_lo(qw) * scale * __expf(b0), q1 = bf_hi(qw) * scale * __expf(b1);
                const float k0 = bf_lo(kw), k1 = bf_hi(kw);
                const unsigned pq = cvt_pk_bf16(q0, q1), pk = cvt_pk_bf16(k0 * __expf(-b0), k1 * __expf(-b1)), ph = cvt_pk_bf16(k0 * __expf(c0 - b0), k1 * __expf(c1 - b1));
                if (e2 < 4) { oq[0][e2] = pq; ok[0][e2] = pk; oh[0][e2] = ph; } else { oq[1][e2 - 4] = pq; ok[1][e2 - 4] = pk; oh[1][e2 - 4] = ph; } }
        }
        *(LAS u32x4*)(Qs + j * 136 + kr) = oq[0]; *(LAS u32x4*)(Qs + j * 136 + kr + 8) = oq[1];
        *(LAS u32x4*)(Ks + j * 136 + kr) = ok[0]; *(LAS u32x4*)(Ks + j * 136 + kr + 8) = ok[1];
        *(LAS u32x4*)(Kh + j * 136 + kr) = oh[0]; *(LAS u32x4*)(Kh + j * 136 + kr + 8) = oh[1];
        bf16_t* qt = QT + (size_t)(tok0 + j) * QKD + h * DK + kr; *(u32x4*)qt = oq[0]; *(u32x4*)(qt + 8) = oq[1];
        if (tid < DK) EB[((size_t)bh * NCH + c) * DK + tid] = __expf((Tt[tid] + Tt[128 + tid]) + (Tt[256 + tid] + Tt[384 + tid]));
    }
    __syncthreads();
    {
        const int it = wid >> 1, jt0 = (wid & 1) * 2; f32x4 a[2] = {{0.f, 0.f, 0.f, 0.f}, {0.f, 0.f, 0.f, 0.f}};
#pragma unroll
        for (int ks = 0; ks < 4; ++ks) { const bf16x8 y = *(const LAS bf16x8*)(Qs + (16 * it + r) * 136 + 32 * ks + 8 * q);
#pragma unroll
            for (int jj = 0; jj < 2; ++jj) { const bf16x8 x = *(const LAS bf16x8*)(Ks + (16 * (jt0 + jj) + r) * 136 + 32 * ks + 8 * q); a[jj] = MFMA16(x, y, a[jj]); } }
        const int i = 16 * it + r;
#pragma unroll
        for (int jj = 0; jj < 2; ++jj) { const int jb = 16 * (jt0 + jj) + 4 * q; u32x2 w;
            w.x = cvt_pk_bf16(jb + 0 <= i ? a[jj][0] : 0.f, jb + 1 <= i ? a[jj][1] : 0.f); w.y = cvt_pk_bf16(jb + 2 <= i ? a[jj][2] : 0.f, jb + 3 <= i ? a[jj][3] : 0.f);
            *(u32x2*)(AM + (size_t)uidx * 4096 + i * 64 + jb) = w; }
    }
    {
        f32x4 acc[2][8];
#pragma unroll
        for (int a = 0; a < 2; ++a)
#pragma unroll
            for (int yt = 0; yt < 8; ++yt) acc[a][yt] = (f32x4){0.f, 0.f, 0.f, 0.f};
#pragma unroll
        for (int ks = 0; ks < 2; ++ks) { bf16x8 x[2];
#pragma unroll
            for (int a = 0; a < 2; ++a) x[a] = tr_frag<272>(Vn, 2 * wid + a, ks, lane);
#pragma unroll
            for (int yt = 0; yt < 8; ++yt) { const bf16x8 y = tr_frag<136>(Kh, yt, ks, lane);
#pragma unroll
                for (int a = 0; a < 2; ++a) acc[a][yt] = MFMA16(x[a], y, acc[a][yt]); } }
        bf16_t* sp = SUB + ((size_t)bh * NCH + c) * (DK * DV);
#pragma unroll
        for (int a = 0; a < 2; ++a)
#pragma unroll
            for (int yt = 0; yt < 8; ++yt) { u32x2 w; w.x = cvt_pk_bf16(acc[a][yt][0], acc[a][yt][1]); w.y = cvt_pk_bf16(acc[a][yt][2], acc[a][yt][3]); *(u32x2*)(sp + (16 * yt + r) * DV + 32 * wid + 16 * a + 4 * q) = w; }
    }
    __syncthreads();
}
__device__ __forceinline__ void gla_passC(LAS unsigned char* lds, int uidx, const bf16_t* PR, const bf16_t* SUB, const bf16_t* QT, const bf16_t* AM, const float* gn  ,
                                          bf16_t* Y, int tid, int wid, int lane) {
    const int b = uidx >> 7, c = (uidx >> 2) & 31, h = uidx & 3; const int tok0 = b * SEQ + c * 64; const int bh = b * 4 + h;
    LAS bf16_t* Qs = (LAS bf16_t*)lds;
    LAS bf16_t* As = (LAS bf16_t*)(lds + 17408);
    LAS bf16_t* Vn = (LAS bf16_t*)(lds + 26624);
    LAS bf16_t* Sn = (LAS bf16_t*)(lds + 61440);
    LAS float* Of = (LAS float*)(lds + 61440);
    const int r = lane & 15, q = lane >> 4;
    u32x4 ogr[4];
    { const bf16_t* gp0 = PR + (size_t)(tok0 + (tid >> 3)) * PRW + 3072 + h * DV + (tid & 7) * 32;
#pragma unroll
      for (int j = 0; j < 4; ++j) ogr[j] = *(const u32x4*)(gp0 + 8 * j); }
    { const bf16_t* sp = SUB + ((size_t)bh * NCH + c) * (DK * DV);
#pragma unroll
      for (int i = 0; i < 8; ++i) { const int id = tid + 512 * i, k = id >> 5, cc = id & 31; *(LAS u32x4*)(Sn + k * 272 + cc * 8) = *(const u32x4*)(sp + k * DV + cc * 8); } }
#pragma unroll
    for (int i = 0; i < 2; ++i) { const int id = tid + 512 * i, row = id >> 4, cc = id & 15; *(LAS u32x4*)(Qs + row * 136 + cc * 8) = *(const u32x4*)(QT + (size_t)(tok0 + row) * QKD + h * DK + cc * 8); }
    { const int row = tid >> 3, cc = tid & 7; *(LAS u32x4*)(As + row * 72 + cc * 8) = *(const u32x4*)(AM + (size_t)uidx * 4096 + row * 64 + cc * 8); }
    stage_v(Vn, PR, tok0, h, tid);
    __syncthreads();
    f32x4 acc[2][4];
#pragma unroll
    for (int a = 0; a < 2; ++a)
#pragma unroll
        for (int it = 0; it < 4; ++it) acc[a][it] = (f32x4){0.f, 0.f, 0.f, 0.f};
#pragma unroll
    for (int ks = 0; ks < 4; ++ks) { bf16x8 x[2];
#pragma unroll
        for (int a = 0; a < 2; ++a) x[a] = tr_frag<272>(Sn, 2 * wid + a, ks, lane);
#pragma unroll
        for (int it = 0; it < 4; ++it) { const bf16x8 y = *(const LAS bf16x8*)(Qs + (16 * it + r) * 136 + 32 * ks + 8 * q);
#pragma unroll
            for (int a = 0; a < 2; ++a) acc[a][it] = MFMA16(x[a], y, acc[a][it]); } }
#pragma unroll
    for (int ks = 0; ks < 2; ++ks) { bf16x8 x[2];
#pragma unroll
        for (int a = 0; a < 2; ++a) x[a] = tr_frag<272>(Vn, 2 * wid + a, ks, lane);
#pragma unroll
        for (int it = 0; it < 4; ++it) { const bf16x8 y = *(const LAS bf16x8*)(As + (16 * it + r) * 72 + 32 * ks + 8 * q);
#pragma unroll
            for (int a = 0; a < 2; ++a) acc[a][it] = MFMA16(x[a], y, acc[a][it]); } }
    __syncthreads();
#pragma unroll
    for (int a = 0; a < 2; ++a)
#pragma unroll
        for (int it = 0; it < 4; ++it) *(LAS f32x4*)(Of + (16 * it + r) * 260 + 32 * wid + 16 * a + 4 * q) = acc[a][it];
    __syncthreads();
    { const int i = tid >> 3, seg = tid & 7; f32x4 o[8]; float ss = 0.f;
#pragma unroll
      for (int j = 0; j < 8; ++j) { o[j] = *(const LAS f32x4*)(Of + i * 260 + seg * 32 + 4 * j); ss += (o[j].x * o[j].x + o[j].y * o[j].y) + (o[j].z * o[j].z + o[j].w * o[j].w); }
      ss += __shfl_xor(ss, 1); ss += __shfl_xor(ss, 2); ss += __shfl_xor(ss, 4);
      const float rstd = rsqrtf(ss * (1.f / DV) + EPS);
      const bf16_t* gp = PR + (size_t)(tok0 + i) * PRW + 3072 + h * DV + seg * 32; const float* gnp = gn + h * DV + seg * 32; bf16_t* yp = Y + (size_t)(tok0 + i) * DM + 1024 + h * DV + seg * 32;
#pragma unroll
      for (int j = 0; j < 4; ++j) { const u32x4 g = ogr[j]; const f32x4 n0 = *(const f32x4*)(gnp + 8 * j), n1 = *(const f32x4*)(gnp + 8 * j + 4); const f32x4 a0 = o[2 * j], a1 = o[2 * j + 1]; u32x4 w;
          w.x = cvt_pk_bf16(a0.x * rstd * n0.x * silu_f(bf_lo(g.x)), a0.y * rstd * n0.y * silu_f(bf_hi(g.x)));
          w.y = cvt_pk_bf16(a0.z * rstd * n0.z * silu_f(bf_lo(g.y)), a0.w * rstd * n0.w * silu_f(bf_hi(g.y)));
          w.z = cvt_pk_bf16(a1.x * rstd * n1.x * silu_f(bf_lo(g.z)), a1.y * rstd * n1.y * silu_f(bf_hi(g.z)));
          w.w = cvt_pk_bf16(a1.z * rstd * n1.z * silu_f(bf_lo(g.w)), a1.w * rstd * n1.w * silu_f(bf_hi(g.w)));
          *(u32x4*)(yp + 8 * j) = w; } }
    __syncthreads();
}
__device__ __forceinline__ float prs_sum(const float* PRS, int s, int col) { float v = 0.f;
#pragma unroll
    for (int sp = 0; sp < NSP1; ++sp) v += PRS[((size_t)sp * NS + s) * PRSW + col];
    return v; }
__device__ __forceinline__ f32x4 prs_sum4(const float* PRS, int s, int col) { f32x4 v = {0.f, 0.f, 0.f, 0.f};
#pragma unroll
    for (int sp = 0; sp < NSP1; ++sp) v += *(const f32x4*)(PRS + ((size_t)sp * NS + s) * PRSW + col);
    return v; }
template <bool WITH_O> __device__ __forceinline__ void gla_sample(LAS unsigned char* lds, int uidx, const float* PRS, const float* GLRP, const float* w2, const float* gb, const float* gn,
                                           const float* s_in  , float* s_out  , bf16_t* Y, int tid, int wid, int lane) {
    const int s = uidx >> 2, h = uidx & 3; const int row = MP + s;
    LAS float* smA = (LAS float*)lds; LAS float* smK = smA + 128; LAS float* smQ = smK + 128; LAS float* smO = smQ + 128; LAS float* smR = smO + 2048;
    const size_t sb = ((size_t)(s * 4 + h) * DK) * DV + (tid & 63) * 4; f32x4 S[16];
#pragma unroll
    for (int kk = 0; kk < 16; ++kk) S[kk] = __builtin_nontemporal_load((const f32x4*)(s_in + sb + (size_t)(16 * wid + kk) * DV));
    if (tid < DK) { const int col = h * DK + tid; float z = gb[col];
#pragma unroll
        for (int rr = 0; rr < RANK; ++rr) { float g = 0.f;
#pragma unroll
            for (int sp = 0; sp < NSP1; ++sp) g += GLRP[((size_t)sp * MPAD + row) * RANK + rr];
            z += g * w2[rr * QKD + col]; }
        smA[tid] = __expf(logsig_f(z) * (1.f / 16.f)); smK[tid] = prs_sum(PRS, s, 3584 + col); if (WITH_O) smQ[tid] = prs_sum(PRS, s, 3072 + col) * 0.08838834764831845f; }
    const int dv4 = (tid & 63) * 4; const f32x4 v = prs_sum4(PRS, s, 4096 + h * DV + dv4);
    __syncthreads();
    f32x4 o = {0.f, 0.f, 0.f, 0.f};
#pragma unroll
    for (int kk = 0; kk < 16; ++kk) { const int k = 16 * wid + kk; const f32x4 sn = S[kk] * smA[k] + v * smK[k]; if (!WITH_O || !DEFER_STATE) __builtin_nontemporal_store(sn, (f32x4*)(s_out + sb + (size_t)k * DV)); if (WITH_O) o += sn * smQ[k]; }
    if (!WITH_O) { __syncthreads(); return; }
    *(LAS f32x4*)(smO + wid * 256 + dv4) = o;
    __syncthreads();
    float oo = 0.f;
    if (tid < 256) {
#pragma unroll
        for (int w = 0; w < 8; ++w) oo += smO[w * 256 + tid];
        const float ss = wave_sum(oo * oo); if (lane == 0) smR[wid] = ss; }
    __syncthreads();
    if (tid < 256) { const float tot = (smR[0] + smR[1]) + (smR[2] + smR[3]); const float rstd = rsqrtf(tot * (1.f / DV) + EPS);
        const float og = prs_sum(PRS, s, 5120 + h * DV + tid); Y[(size_t)row * DM + 1024 + h * DV + tid] = f2bf(oo * rstd * gn[h * DV + tid] * silu_f(og)); }
    __syncthreads();
}
__device__ __forceinline__ void sample_assemble(const float* base, const float* XSP, int nsp, int s, float* xr, int lane) {
    const f32x4* br = (const f32x4*)base + lane; f32x4* o = (f32x4*)xr + lane;
#pragma unroll
    for (int j = 0; j < 8; ++j) { f32x4 v = br[64 * j];
        for (int sp = 0; sp < nsp; ++sp) v += *((const f32x4*)(XSP + ((size_t)sp * NS + s) * DM) + lane + 64 * j);
        o[64 * j] = v; }
}

template <int PH> struct MixOrder {
    pg8::StaticOrder so; int nfull, ntfull;
    __device__ __forceinline__ void init(int Ncols, int ntf, int G, int c) { so.init(MP, Ncols, G, c); nfull = so.nwg; ntfull = ntf; }
    __device__ __forceinline__ bool next(int i, pg8::Unit& u) const {
        const long L = (long)i * so.G + so.c; int pm = 32, pn = 0, sp = -1, k0 = 0, nt = ntfull; bool ok = true;
        if (L < nfull) { pg8::Unit t; so.next(i, t); pm = t.pm; pn = t.pn; }
        else { const int mi = (int)(L - nfull);
            if (PH == 1) { ok = mi < 57 * NSP1;
                const bool isg = mi < 33 * NSP1; const int m2 = isg ? mi : mi - 33 * NSP1; const int qd = m2 / NSP1; sp = m2 - qd * NSP1; pm = isg ? qd : 32; pn = isg ? 24 : qd; nt = 32 / NSP1; k0 = sp * (32 / NSP1); }
            else if (PH == 2) { ok = mi < 64; pn = mi >> 3; sp = mi & 7; k0 = sp * 4; nt = 4; }
            else if (PH == 3) { ok = mi < 44; pn = mi; nt = 32; }
            else { ok = mi < 88; pn = mi / 11; sp = mi - 11 * pn; k0 = sp * 8; nt = 8; }
        }
        u.pm = pm; u.pn = pn; u.sp = sp; u.k0 = k0; u.nt = nt; return ok;
    }
    __device__ __forceinline__ void a_ready(const pg8::Unit&) const {}
    __device__ __forceinline__ void done(const pg8::Unit&) const {}
};

#define XB_TMO      128
#define XB_XCNT(j)  (256  + 64 * (j))
#define XB_XSUB(j)  (1280 + 64 * (j))
#define XB_XGEN(j)  (2304 + 64 * (j))
#define XB_TOP      3328
#define XB_TOPGEN   3392
#define XCD_BAR_WORDS 3456
#define XB_SPIN_CAP (1u << 18)

__device__ __forceinline__ unsigned xb_ld(unsigned* p)              { return __hip_atomic_load(p, __ATOMIC_RELAXED, __HIP_MEMORY_SCOPE_AGENT); }
__device__ __forceinline__ unsigned xb_add(unsigned* p, unsigned v) { return __hip_atomic_fetch_add(p, v, __ATOMIC_RELAXED, __HIP_MEMORY_SCOPE_AGENT); }
__device__ __forceinline__ unsigned xb_xcc_id() { return (unsigned)__builtin_amdgcn_s_getreg((3 << 11) | 20) & 0xFu; }
#define XB_SPIN(cond, bar) do { unsigned _sp = 0; while (cond) { __builtin_amdgcn_s_sleep(1); \
    if ((++_sp & 255u) == 0u) { if (xb_ld(&(bar)[XB_TMO])) break; if (_sp > XB_SPIN_CAP) { atomicAdd(&(bar)[XB_TMO], 1u); break; } } } } while (0)

struct XcdBarrier {
    unsigned* bar; unsigned x;
    volatile LAS unsigned* st;
};

__device__ __forceinline__ XcdBarrier xcd_barrier_post(unsigned* bar, volatile LAS unsigned* st) {
    XcdBarrier b; b.bar = bar; b.x = xb_xcc_id(); b.st = st;
    if (threadIdx.x == 0) (void)xb_add(&bar[XB_XCNT(b.x)], 1u);
    return b;
}
__device__ __forceinline__ void xcd_barrier_complete(unsigned* bar, unsigned x, unsigned& nloc, unsigned& nx) {
    const unsigned G = gridDim.x * gridDim.y * gridDim.z;
    unsigned sum, cnt, mine, sp = 0u;
    for (;;) {
        sum = 0u; cnt = 0u; mine = 0u;
#pragma unroll
        for (unsigned j = 0; j < 16; ++j) { const unsigned c = xb_ld(&bar[XB_XCNT(j)]); sum += c; cnt += (c > 0u) ? 1u : 0u; mine = (j == x) ? c : mine; }
        if (sum == G) break;
        __builtin_amdgcn_s_sleep(1);
        if ((++sp & 255u) == 0u) { if (xb_ld(&bar[XB_TMO])) break; if (sp > XB_SPIN_CAP) { atomicAdd(&bar[XB_TMO], 1u); break; } }
    }
    nloc = mine > 0u ? mine : 1u; nx = cnt > 0u ? cnt : 1u;
}

__device__ __forceinline__ void xcd_barrier(const XcdBarrier& b) {
    asm volatile("s_waitcnt vmcnt(0)" ::: "memory");
    __syncthreads();
    if (threadIdx.x == 0) {
        unsigned* bar = b.bar;
        __builtin_amdgcn_s_waitcnt(0);
        unsigned nloc = b.st[0], nx = b.st[1];
        if (nloc == 0u) { xcd_barrier_complete(bar, b.x, nloc, nx); b.st[0] = nloc; b.st[1] = nx; }
        const unsigned old = xb_add(&bar[XB_XSUB(b.x)], 1u);
        const unsigned gen = old / nloc;
        if (old + 1u == (gen + 1u) * nloc) {
            __builtin_amdgcn_fence(__ATOMIC_RELEASE, "agent");
            asm volatile("s_waitcnt vmcnt(0)" ::: "memory");
            const unsigned og = xb_add(&bar[XB_TOP], 1u);
            const unsigned tg = og / nx;
            if (og + 1u == (tg + 1u) * nx) xb_add(&bar[XB_TOPGEN], 1u);
            else XB_SPIN(xb_ld(&bar[XB_TOPGEN]) == tg, bar);
            __builtin_amdgcn_fence(__ATOMIC_ACQUIRE, "agent");
            xb_add(&bar[XB_XGEN(b.x)], 1u);
            asm volatile("s_waitcnt vmcnt(0)" ::: "memory");
        } else {
            XB_SPIN(xb_ld(&bar[XB_XGEN(b.x)]) == gen, bar);
            __builtin_amdgcn_fence(__ATOMIC_ACQUIRE, "agent");
            asm volatile("s_waitcnt vmcnt(0)" ::: "memory");
        }
    }
    __syncthreads();
}

struct Args { const float* in[18]; float* out; unsigned char* ws; };
__global__ void __launch_bounds__(NTHR, 2) fwd_kernel(Args a) {
    extern __shared__ __attribute__((aligned(16))) unsigned char lds_raw[];
    LAS unsigned char* lds = (LAS unsigned char*)lds_raw;
    cg::grid_group grid = cg::this_grid();
    if (threadIdx.x < 2) ((volatile LAS unsigned*)(lds + LDS_BARST))[threadIdx.x] = 0u;
    if (blockIdx.x == 0) { unsigned* bw = (unsigned*)(a.ws + WS_BAR); for (int i = threadIdx.x; i < XCD_BAR_WORDS; i += NTHR) __hip_atomic_store(bw + i, 0u, __ATOMIC_RELAXED, __HIP_MEMORY_SCOPE_AGENT); }
    const int G = gridDim.x, bid = blockIdx.x; const int NGW = G * 8, NGT = G * NTHR;
#define PHASE_IDS KP_DECL int tid = threadIdx.x; asm volatile("" : "+v"(tid)); const int lane = tid & 63; const int wid = __builtin_amdgcn_readfirstlane(tid >> 6); const int gw = bid * 8 + wid; const int gt = bid * NTHR + tid; (void)gw; (void)gt; (void)lane;
    typedef const __attribute__((address_space(4))) unsigned char* kargp_t;
#define KP_DECL kargp_t kp_ = (kargp_t)__builtin_amdgcn_kernarg_segment_ptr(); asm volatile("" : "+s"(kp_));
#define KIN(i) (*(const __attribute__((address_space(4))) float* const __attribute__((address_space(4)))*)(kp_ + 8 * (i)))
#define KPTR(i) (*(unsigned char* const __attribute__((address_space(4)))*)(kp_ + 8 * (i)))
#define x_prompt ((const float*)KPTR(0))
#define x_sample ((const float*)KPTR(1))
#define state_conv ((const float*)KPTR(2))
#define state_gla ((const float*)KPTR(3))
#define state_ffn ((const float*)KPTR(4))
#define norm_mix_g ((const float*)KPTR(5))
#define w_in ((const float*)KPTR(6))
#define conv_w ((const float*)KPTR(7))
#define gate_w2 ((const float*)KPTR(8))
#define gate_b ((const float*)KPTR(9))
#define gla_norm_g ((const float*)KPTR(10))
#define w_out ((const float*)KPTR(11))
#define norm_ffn_g ((const float*)KPTR(12))
#define w_up ((const float*)KPTR(13))
#define ffn_conv_w ((const float*)KPTR(14))
#define ffn_conv_b ((const float*)KPTR(15))
#define w_down ((const float*)KPTR(16))
#define final_norm_g ((const float*)KPTR(17))
#define out ((float*)KPTR(18))
#define ws (KPTR(19))
#define WT_IN ((bf16_t*)(ws + WS_WIN))
#define WT_OUT ((bf16_t*)(ws + WS_WOUT))
#define WT_UP ((bf16_t*)(ws + WS_WUP))
#define WT_DN ((bf16_t*)(ws + WS_WDN))
#define XN ((bf16_t*)(ws + WS_XN))
#define XR ((float*)(ws + WS_XR))
#define PR ((bf16_t*)(ws + WS_PR))
#define UC ((float*)(ws + WS_UC))
#define Y ((bf16_t*)(ws + WS_Y))
#define SUB ((bf16_t*)(ws + WS_SU))
#define EB ((float*)(ws + WS_EB))
#define QT ((bf16_t*)(ws + WS_QT))
#define AM ((bf16_t*)(ws + WS_AM))
#define PRS ((float*)(ws + WS_PRS))
#define GLRP ((float*)(ws + WS_GLRP))
#define XSP ((float*)(ws + WS_XSP))
#define H ((bf16_t*)(ws + WS_H))
#define TAIL ((float*)(ws + WS_TAIL))
#define SSB ((float*)(ws + WS_SS))
#define SSP ((float*)(ws + WS_SSP))
#define HEAD ((float*)(ws + WS_HEAD))

    for (int rp_ = 0; rp_ < REP_P0; ++rp_) {
        PHASE_IDS
        LAS float* scr = (LAS float*)(lds + wid * 16384);
#if P0_WG
        { const P0Src ts{w_in, w_out, w_up, w_down, norm_mix_g, norm_ffn_g, WT_IN, WT_OUT, WT_UP, WT_DN}; LAS float* T = (LAS float*)lds;
          int it = bid; P0Desc dc, dn; f32x4 tv[8];
          bool have = p0_decode(it, ts, wid, lane, dc); if (have) p0_load(dc, tv);
          while (have) {
              p0_to_lds(dc, tv, T, wid, lane);
              __syncthreads();
              const bool hn = p0_decode(it + G, ts, wid, lane, dn); if (hn) p0_load(dn, tv);
              p0_out(dc, T, wid, lane);
              __syncthreads();
              have = hn; it += G; dc = dn;
          } }
#else
        constexpr int I_IN = 200 * 32, I_OUT = 64 * 32, I_UP = 352 * 32, I_DN = 64 * 88, I_L = I_IN + I_OUT + I_UP + I_DN;
        for (int it = gw; it < 2 * I_L; it += NGW) {
            const int l = it / I_L; int rr = it - l * I_L;
            if (rr < I_IN) { const int g = rr >> 5, kb = rr & 31; int src, nv; bool perm; win_map(g, src, nv, perm);
                tr_item(w_in + (size_t)l * DM * INC, INC, nv, DM, WT_IN + (size_t)l * INP * DM, g * 32, src, perm, kb, scr, lane, norm_mix_g + (size_t)l * DM); continue; }
            rr -= I_IN;
            if (rr < I_OUT) { const int g = rr >> 5, kb = rr & 31; tr_item(w_out + (size_t)l * DM * DM, DM, DM, DM, WT_OUT + (size_t)l * DM * DM, g * 32, g * 32, false, kb, scr, lane); continue; }
            rr -= I_OUT;
            if (rr < I_UP) { const int g = rr >> 5, kb = rr & 31; const int tile = g >> 3, gi = g & 7; const int src = (gi < 4) ? (128 * tile + 32 * gi) : (DFF + 128 * tile + 32 * (gi - 4));
                tr_item(w_up + (size_t)l * DM * UPN, UPN, UPN, DM, WT_UP + (size_t)l * UPN * DM, g * 32, src, true, kb, scr, lane, norm_ffn_g + (size_t)l * DM); continue; }
            rr -= I_UP;
            { const int g = rr / 88, kb = rr - g * 88; tr_item(w_down + (size_t)l * DFF * DM, DM, DM, DFF, WT_DN + (size_t)l * DM * DFF, g * 32, g * 32, false, kb, scr, lane); }
        }
#endif
        for (int m = gw; m < MPAD; m += NGW) {
            if (m < MREAL) row_bf16_ss(m < MP ? x_prompt + (size_t)m * DM : x_sample + (size_t)(m - MP) * DM, XN + (size_t)m * DM, SSB + m, lane);
            else { u32x4* o = (u32x4*)(XN + (size_t)m * DM) + lane; const u32x4 z = {0u, 0u, 0u, 0u};
#pragma unroll
                for (int j = 0; j < 4; ++j) o[64 * j] = z;
                if (lane == 0) SSB[m] = 0.f; }
        }
        for (int i = gt; i < 3 * MPAD; i += NGT) SSB[MPAD + i] = 0.f;
    }
    grid.sync();
    unsigned* barw_; { KP_DECL barw_ = (unsigned*)(ws + WS_BAR); }
    XcdBarrier xbar; xbar.bar = barw_; xbar.x = xb_xcc_id(); xbar.st = (volatile LAS unsigned*)(lds + LDS_BARST);
#define GRID_BAR() xcd_barrier(xbar)
    volatile LAS unsigned* vcw = (volatile LAS unsigned*)(lds + LDS_BARST + 16);
    if (threadIdx.x == 0) vcw[0] = xb_add(&barw_[XB_XCNT(xbar.x)], 1u);
    GRID_BAR();
    if (threadIdx.x == 0) { bool even = (G == 256);
        for (unsigned j = 0; j < 8; ++j) even = even && (xb_ld(&barw_[XB_XCNT(j)]) == 32u);
        vcw[1] = even ? vcw[0] * 8u + xbar.x : (unsigned)bid; }
    __syncthreads();
    const int vcu = __builtin_amdgcn_readfirstlane((int)vcw[1]);

#pragma unroll 1
    for (int l = 0; l < 2; ++l) {
        for (int rp_ = 0; rp_ < REP_G1; ++rp_) { KP_DECL pg8::Gemm g{XN, WT_IN + (size_t)l * INP * DM, MPAD, INP, DM}; MixOrder<1> S; S.init(6144, 32, G, vcu);
          EpiIn E{PR, UC, GLRP, PRS, SSB + (size_t)(2 * l) * MPAD, out + O_CP + (size_t)l * NBATCH * 2 * CONVD};
          pg8::gemm_phase<EpiIn, MixOrder<1>, true, true>(lds, g, S, E); }
        GRID_BAR();
        for (int rp_ = 0; rp_ < REP_M1; ++rp_) {
            PHASE_IDS
            const float* w2 = gate_w2 + (size_t)l * RANK * QKD; const float* gb = gate_b + (size_t)l * QKD; const float* gn = gla_norm_g + (size_t)l * 1024;
            for (int ra_ = 0; ra_ < REP_M1A; ++ra_) for (int u = bid; u < 512; u += G) gla_passA(lds, u, PR, GLRP, w2, gb, SUB, EB, QT, AM, tid, wid, lane);
            for (int rs_ = 0; rs_ < REP_M1S; ++rs_) for (int u = bid; u < 512; u += G) gla_sample<true>(lds, u, PRS, GLRP, w2, gb, gn, state_gla + (size_t)l * NS * NH * DK * DV, out + O_GS + (size_t)l * NS * NH * DK * DV, Y, tid, wid, lane);
            const float* cw = conv_w + (size_t)l * 3 * CONVD;
            for (int rc_ = 0; rc_ < REP_M1C; ++rc_) for (int item = gt; item < (MP / 8) * 128; item += NGT) {
                const int c8 = (item & 127) * 8, row0 = (item >> 7) * 8; const bool cont = (row0 & (SEQ - 1)) != 0; const bf16_t* up = (const bf16_t*)UC + (size_t)row0 * CONVD + c8; const u32x4 z4 = {0u, 0u, 0u, 0u};
                u32x4 ub[10], bg[8];
                ub[0] = cont ? *(const u32x4*)(up - 2 * CONVD) : z4; ub[1] = cont ? *(const u32x4*)(up - CONVD) : z4;
#pragma unroll
                for (int i = 0; i < 8; ++i) { ub[2 + i] = *(const u32x4*)(up + (size_t)i * CONVD); bg[i] = *(const u32x4*)(PR + (size_t)(row0 + i) * PRW + c8); }
                f32x4 wv[3][2];
#pragma unroll
                for (int t = 0; t < 3; ++t) { wv[t][0] = *(const f32x4*)(cw + t * CONVD + c8); wv[t][1] = *(const f32x4*)(cw + t * CONVD + c8 + 4); }
#pragma unroll
                for (int i = 0; i < 8; ++i) { u32x4 w;
#pragma unroll
                    for (int hh = 0; hh < 2; ++hh) { const unsigned a0 = hh ? ub[i].z : ub[i].x, a1 = hh ? ub[i].w : ub[i].y, b0 = hh ? ub[i + 1].z : ub[i + 1].x, b1 = hh ? ub[i + 1].w : ub[i + 1].y, c0 = hh ? ub[i + 2].z : ub[i + 2].x, c1 = hh ? ub[i + 2].w : ub[i + 2].y;
                        const unsigned g0 = hh ? bg[i].z : bg[i].x, g1 = hh ? bg[i].w : bg[i].y;
                        const f32x4 u2 = {bf_lo(a0), bf_hi(a0), bf_lo(a1), bf_hi(a1)}, u1 = {bf_lo(b0), bf_hi(b0), bf_lo(b1), bf_hi(b1)}, u0 = {bf_lo(c0), bf_hi(c0), bf_lo(c1), bf_hi(c1)}, bgf = {bf_lo(g0), bf_hi(g0), bf_lo(g1), bf_hi(g1)};
                        const f32x4 cu = (u2 * wv[0][hh] + u1 * wv[1][hh] + u0 * wv[2][hh]) * bgf;
                        if (hh == 0) { w.x = cvt_pk_bf16(cu.x, cu.y); w.y = cvt_pk_bf16(cu.z, cu.w); } else { w.z = cvt_pk_bf16(cu.x, cu.y); w.w = cvt_pk_bf16(cu.z, cu.w); } }
                    *(u32x4*)(Y + (size_t)(row0 + i) * DM + c8) = w; }
            }
            for (int idx = gt; idx < NS * 256; idx += NGT) { const int s = idx >> 8, c4 = (idx & 255) * 4; const int row = MP + s;
                const f32x4 u0 = prs_sum4(PRS, s, 1024 + c4) * prs_sum4(PRS, s, 2048 + c4), bgf = prs_sum4(PRS, s, c4);
                const float* sp = state_conv + ((size_t)l * NS + s) * 2 * CONVD + c4; const f32x4 u2 = *(const f32x4*)sp, u1 = *(const f32x4*)(sp + CONVD);
                float* op = out + O_CS + ((size_t)l * NS + s) * 2 * CONVD + c4; *(f32x4*)op = u1; *(f32x4*)(op + CONVD) = u0;
                const f32x4 w0 = *(const f32x4*)(cw + c4), w1 = *(const f32x4*)(cw + CONVD + c4), w2v = *(const f32x4*)(cw + 2 * CONVD + c4);
                const f32x4 cu = (u2 * w0 + u1 * w1 + u0 * w2v) * bgf;
                u32x2 w; w.x = cvt_pk_bf16(cu.x, cu.y); w.y = cvt_pk_bf16(cu.z, cu.w);
                *(u32x2*)(Y + (size_t)row * DM + c4) = w; }
        }
        GRID_BAR();
        { PHASE_IDS
        for (int e = gt; e < 16 * DK * 64; e += NGT) { const int bh = e >> 13, rem = e & 8191, k = rem >> 6, dq = rem & 63;
            bf16_t* sp = SUB + (size_t)bh * NCH * (DK * DV) + k * DV + 4 * dq; const float* ep = EB + (size_t)bh * NCH * DK + k; f32x4 S = {0.f, 0.f, 0.f, 0.f};
#pragma unroll 1
            for (int c0 = 0; c0 < NCH; c0 += 16) { u32x2 uu[16]; float ee[16];
#pragma unroll
                for (int i = 0; i < 16; ++i) { uu[i] = *(const u32x2*)(sp + (size_t)(c0 + i) * (DK * DV)); ee[i] = ep[(c0 + i) * DK]; }
#pragma unroll
                for (int i = 0; i < 16; ++i) { u32x2 w; w.x = cvt_pk_bf16(S.x, S.y); w.y = cvt_pk_bf16(S.z, S.w); *(u32x2*)(sp + (size_t)(c0 + i) * (DK * DV)) = w;
                    S = S * ee[i] + (f32x4){bf_lo(uu[i].x), bf_hi(uu[i].x), bf_lo(uu[i].y), bf_hi(uu[i].y)}; } }
            *(f32x4*)(out + O_GP + ((size_t)l * 16 + bh) * (DK * DV) + k * DV + 4 * dq) = S; } }
        GRID_BAR();
        for (int rp_ = 0; rp_ < REP_M3; ++rp_) { PHASE_IDS const float* gn = gla_norm_g + (size_t)l * 1024; for (int u = bid; u < 512; u += G) gla_passC(lds, u, PR, SUB, QT, AM, gn, Y, tid, wid, lane); }
        GRID_BAR();
        { KP_DECL pg8::Gemm g{Y, WT_OUT + (size_t)l * DM * DM, MPAD, DM, DM}; MixOrder<2> S; S.init(DM, 32, G, vcu);
          EpiRes E{l == 0 ? x_prompt : nullptr, nullptr, XSP, XN, SSP};
          pg8::gemm_phase<EpiRes, MixOrder<2>, true, true>(lds, g, S, E); }
        GRID_BAR();
        for (int rp_ = 0; rp_ < REP_NRM; ++rp_) { PHASE_IDS
              for (int r = gt; r < MP; r += NGT) { const f32x4* sp = (const f32x4*)(SSP + (size_t)r * 32); f32x4 t = sp[0];
#pragma unroll
                  for (int j = 1; j < 8; ++j) t += sp[j];
                  SSB[(size_t)(2 * l + 1) * MPAD + r] = (t.x + t.y) + (t.z + t.w); }
              for (int m = MP + gw; m < MREAL; m += NGW) {
                  if (rp_ == 0) sample_assemble(l == 0 ? x_sample + (size_t)(m - MP) * DM : XR + (size_t)m * DM, XSP, 8, m - MP, XR + (size_t)m * DM, lane);
                  row_bf16_ss(XR + (size_t)m * DM, XN + (size_t)m * DM, SSB + (size_t)(2 * l + 1) * MPAD + m, lane); } }
        GRID_BAR();
        for (int rp_ = 0; rp_ < REP_UP; ++rp_) { KP_DECL pg8::Gemm g{XN, WT_UP + (size_t)l * UPN * DM, MPAD, UPN, DM}; MixOrder<3> S; S.init(UPN, 32, G, vcu);
          EpiUp E{H, ffn_conv_w + (size_t)l * 3 * DFF, ffn_conv_b + (size_t)l * DFF, TAIL, HEAD, state_ffn + (size_t)l * NS * 2 * DFF, out + O_FP + (size_t)l * NBATCH * 2 * DFF, out + O_FS + (size_t)l * NS * 2 * DFF, (LAS float*)(lds + LDS_HALO), SSB + (size_t)(2 * l + 1) * MPAD};
          pg8::gemm_phase<EpiUp, MixOrder<3>, true, true>(lds, g, S, E); }
        {
            PHASE_IDS const int first = (G == 256) ? 172 : 0, nw = G - first;
            const float* w2 = gate_w2 + (size_t)l * RANK * QKD; const float* gb = gate_b + (size_t)l * QKD;
            if (DEFER_STATE && bid >= first) for (int u = bid - first; u < 512; u += nw) gla_sample<false>(lds, u, PRS, GLRP, w2, gb, nullptr, state_gla + (size_t)l * NS * NH * DK * DV, out + O_GS + (size_t)l * NS * NH * DK * DV, nullptr, tid, wid, lane);
        }
        GRID_BAR();
        { PHASE_IDS MixOrder<4> S0; S0.init(DM, 88, G, vcu); pg8::Unit u0;
          for (int ui = 0; S0.next(ui, u0); ++ui) if (u0.sp < 0 && (u0.pm & 7) != 0) { const int pm = u0.pm; const float* cw = ffn_conv_w + (size_t)l * 3 * DFF; const float* cb = ffn_conv_b + (size_t)l * DFF;
            for (int idx = tid; idx < 2 * (DFF / 4); idx += NTHR) { const int j = idx / (DFF / 4), c4 = (idx - j * (DFF / 4)) * 4;
              const f32x4 t0 = *(const f32x4*)(TAIL + ((size_t)(pm - 1) * 2 + 0) * DFF + c4), t1 = *(const f32x4*)(TAIL + ((size_t)(pm - 1) * 2 + 1) * DFF + c4);
              const f32x4 hu0 = *(const f32x4*)(HEAD + ((size_t)pm * 2 + 0) * 2 * DFF + c4), hu1 = *(const f32x4*)(HEAD + ((size_t)pm * 2 + 1) * 2 * DFF + c4), hv = *(const f32x4*)(HEAD + ((size_t)pm * 2 + j) * 2 * DFF + DFF + c4);
              const f32x4 w0 = *(const f32x4*)(cw + c4), w1 = *(const f32x4*)(cw + DFF + c4), w2v = *(const f32x4*)(cw + 2 * DFF + c4), bv = *(const f32x4*)(cb + c4);
              const f32x4 cu = j == 0 ? (t0 * w0 + t1 * w1 + hu0 * w2v + bv) : (t1 * w0 + hu0 * w1 + hu1 * w2v + bv);
              u32x2 w; w.x = cvt_pk_bf16(silu_f(cu.x) * hv.x, silu_f(cu.y) * hv.y); w.y = cvt_pk_bf16(silu_f(cu.z) * hv.z, silu_f(cu.w) * hv.w);
              *(u32x2*)(H + (size_t)(pm * 256 + j) * DFF + c4) = w; }
            asm volatile("s_waitcnt vmcnt(0)" ::: "memory"); }
          __syncthreads(); }
        { KP_DECL pg8::Gemm g{H, WT_DN + (size_t)l * DM * DFF, MPAD, DM, DFF}; MixOrder<4> S; S.init(DM, 88, G, vcu);
          EpiRes E{nullptr, nullptr, XSP, XN, l == 0 ? SSP : nullptr};
          pg8::gemm_phase<EpiRes, MixOrder<4>, true, true>(lds, g, S, E); }
        GRID_BAR();
        if (l == 0) { PHASE_IDS
              for (int r = gt; r < MP; r += NGT) { const f32x4* sp = (const f32x4*)(SSP + (size_t)r * 32); f32x4 t = sp[0];
#pragma unroll
                  for (int j = 1; j < 8; ++j) t += sp[j];
                  SSB[(size_t)2 * MPAD + r] = (t.x + t.y) + (t.z + t.w); }
              for (int m = MP + gw; m < MREAL; m += NGW) { sample_assemble(XR + (size_t)m * DM, XSP, 11, m - MP, XR + (size_t)m * DM, lane);
                  row_bf16_ss(XR + (size_t)m * DM, XN + (size_t)m * DM, SSB + (size_t)2 * MPAD + m, lane); }
            GRID_BAR(); }
    }
    PHASE_IDS
    for (int m = gw; m < MREAL; m += NGW) {
        if (m >= MP) { sample_assemble(XR + (size_t)m * DM, XSP, 11, m - MP, XR + (size_t)m * DM, lane); rms_row_f32(XR + (size_t)m * DM, final_norm_g, out + O_YS + (size_t)(m - MP) * DM, lane); }
        else { const u32x2* xr = (const u32x2*)(XN + (size_t)m * DM) + lane; f32x4 v[8]; float sq = 0.f;
#pragma unroll
            for (int j = 0; j < 8; ++j) { const u32x2 w = xr[64 * j]; v[j] = (f32x4){bf_lo(w.x), bf_hi(w.x), bf_lo(w.y), bf_hi(w.y)}; sq += (v[j].x * v[j].x + v[j].y * v[j].y) + (v[j].z * v[j].z + v[j].w * v[j].w); }
            const float rstd = rsqrtf(wave_sum(sq) * (1.f / DM) + EPS); const f32x4* gr = (const f32x4*)final_norm_g + lane; f32x4* o = (f32x4*)(out + O_YP + (size_t)m * DM) + lane;
#pragma unroll
            for (int j = 0; j < 8; ++j) o[64 * j] = v[j] * rstd * gr[64 * j]; } }
}

#undef x_prompt
#undef x_sample
#undef state_conv
#undef state_gla
#undef state_ffn
#undef norm_mix_g
#undef w_in
#undef conv_w
#undef gate_w2
#undef gate_b
#undef gla_norm_g
#undef w_out
#undef norm_ffn_g
#undef w_up
#undef ffn_conv_w
#undef ffn_conv_b
#undef w_down
#undef final_norm_g
#undef out
#undef ws
#undef WT_IN
#undef WT_OUT
#undef WT_UP
#undef WT_DN
#undef XN
#undef XR
#undef PR
#undef UC
#undef Y
#undef SUB
#undef EB
#undef QT
#undef AM
#undef PRS
#undef GLRP
#undef XSP
#undef H
#undef TAIL
#undef SSB
#undef SSP
#undef HEAD
extern "C" void kernel_launch(void* const* d_in, const int* in_sizes, int n_in, void* d_out, int out_size, void* d_ws, size_t ws_size, hipStream_t stream) {
    static int grid = 0;
    if (grid == 0) {
        if (n_in != 18 || (size_t)out_size != O_TOTAL || ws_size < WS_TOTAL) { fprintf(stderr, "kernel_launch: unexpected shapes: n_in %d out %d ws %zu (need %zu)\n", n_in, out_size, ws_size, (size_t)WS_TOTAL); grid = -1; return; }
        int dev = 0, cus = 0, per_cu = 0;
        hipGetDevice(&dev); hipDeviceGetAttribute(&cus, hipDeviceAttributeMultiprocessorCount, dev);
        if (hipFuncSetAttribute((const void*)fwd_kernel, hipFuncAttributeMaxDynamicSharedMemorySize, LDS_BYTES) != hipSuccess) { fprintf(stderr, "kernel_launch: hipFuncSetAttribute failed\n"); grid = -1; return; }
        if (hipOccupancyMaxActiveBlocksPerMultiprocessor(&per_cu, (const void*)fwd_kernel, NTHR, LDS_BYTES) != hipSuccess || per_cu < 1) { fprintf(stderr, "kernel_launch: occupancy query says %d\n", per_cu); per_cu = 1; }
        (void)hipGetLastError();
        grid = cus;
    }
    if (grid < 0) return;
    Args a{};
    for (int i = 0; i < 18; ++i) a.in[i] = (const float*)d_in[i];
    a.out = (float*)d_out; a.ws = (unsigned char*)d_ws;
    void* args[] = {&a};
    hipError_t e = hipLaunchCooperativeKernel((const void*)fwd_kernel, dim3(grid), dim3(NTHR), args, LDS_BYTES, stream);
    if (e != hipSuccess) fprintf(stderr, "kernel_launch: cooperative launch failed: %s (grid %d)\n", hipGetErrorString(e), grid);
}
```

```cpp
#define TR_GATHER 1
#include <hip/hip_runtime.h>
#include <hip/hip_cooperative_groups.h>
#include <cstdio>
#include <cstdint>
namespace cg = cooperative_groups;
namespace pg8 {
#define PG8_LAS __attribute__((address_space(3)))
typedef unsigned short bf16_t;
typedef short bf16x8 __attribute__((ext_vector_type(8)));
typedef float f32x4 __attribute__((ext_vector_type(4)));
typedef unsigned u32x4 __attribute__((ext_vector_type(4)));
constexpr int BM = 256, BK = 64, HALF = 128, HTB = HALF * BK * 2  , STAGE_BYTES = 8 * HTB, NXCD = 8, WGM = 8;

__host__ __device__ __forceinline__ int lds_byte(int r, int c) { const int st = (r >> 4) * 2 + (c >> 5), rr = r & 15, cc = c & 31, ob = rr * 64 + cc * 2; return st * 1024 + (ob ^ (((ob >> 9) & 1) << 5)); }
__host__ __device__ __forceinline__ void stage_rc(int b, int& R, int& C) { const int st = b / 1024, sb = b % 1024, swz = sb ^ (((sb >> 9) & 1) << 5); R = (st >> 1) * 16 + swz / 64; C = (st & 1) * 32 + (swz % 64) / 2; }
__host__ __device__ __forceinline__ int perm32(int rho) { const int n = rho >> 4, i = rho & 15; return 8 * (i >> 2) + 4 * n + (i & 3); }

struct Unit { int pm, pn, k0, nt, sp; };
struct Gemm { const bf16_t* A; const bf16_t* Bt; int M, N, K; };

struct StaticOrder {
    int nM, nN, nwg, G, c;
    __host__ __device__ void init(int M, int N, int G_, int c_) { nM = M / BM; nN = N / BM; nwg = nM * nN; G = G_; c = c_; }
    __host__ __device__ bool next(int i, Unit& u) const {
        const long L = (long)i * G + c; if (L >= nwg) return false;
        int wgid = (int)L; { const int q = nwg / NXCD, r = nwg % NXCD, xcd = wgid % NXCD, off = wgid / NXCD; wgid = (xcd < r ? xcd * (q + 1) : r * (q + 1) + (xcd - r) * q) + off; }
        const int nig = WGM * nN, gid = wgid / nig, fm = gid * WGM, gsz = (nM - fm) < WGM ? (nM - fm) : WGM;
        u.pm = fm + ((wgid % nig) % gsz); u.pn = (wgid % nig) / gsz; u.k0 = 0; u.sp = -1; return true;
    }
    __device__ __forceinline__ void a_ready(const Unit&) const {}
    __device__ __forceinline__ void done(const Unit&) const {}
};
__device__ __forceinline__ unsigned cvt_pk_bf16(float lo, float hi) { unsigned r; asm volatile("v_cvt_pk_bf16_f32 %0, %1, %2" : "=v"(r) : "v"(lo), "v"(hi)); return r; }
typedef float f32x2 __attribute__((ext_vector_type(2)));
template <class Epi, class Sched, bool ALIGN_EPI = false, bool SP2 = false>
__device__ __forceinline__ void gemm_phase(PG8_LAS unsigned char* lds, const Gemm g, const Sched& S, const Epi& E) {
    int tid = threadIdx.x; asm volatile("" : "+v"(tid)); const int wid = __builtin_amdgcn_readfirstlane(tid >> 6), lane = tid & 63, wr = wid >> 2, wc = wid & 3, fr = lane & 15, fq = lane >> 4;
    const int K = g.K;
    unsigned voffA[2], voffB[2];
#pragma unroll
    for (int i = 0; i < 2; ++i) { int R, C; stage_rc(tid * 16 + i * 8192, R, C); const int Rb = Epi::PERM ? ((R & ~31) + perm32(R & 31)) : R;
        voffA[i] = (unsigned)(R * K + C) * 2u; voffB[i] = (unsigned)(Rb * K + C) * 2u; }
    const size_t kstep = (size_t)(BK * 2);
    const size_t hstep = (size_t)HALF * K * 2;
    const size_t tstep = 2 * hstep;
    const unsigned ldsw = (unsigned)wid * 1024u;
    const int aoff = lds_byte(wr * 64 + fr, fq * 8), boff = lds_byte(wc * 32 + fr, fq * 8);
#define PG8_SA(b, h) (((b) * 2 + (h)) * HTB)
#define PG8_SB(b, h) ((4 + (b) * 2 + (h)) * HTB)
#define PG8_STAGE(bufoff, gbase, voff) do { _Pragma("unroll") for (int _i = 0; _i < 2; ++_i) \
        __builtin_amdgcn_global_load_lds((const unsigned*)((const char*)(gbase) + (voff)[_i]), (PG8_LAS unsigned*)(lds + (bufoff) + ldsw + _i * 8192), 16, 0, 0); } while (0)
#define PG8_LDA(dst, b, h) do { _Pragma("unroll") for (int m = 0; m < 4; ++m) _Pragma("unroll") for (int k = 0; k < 2; ++k) dst[m][k] = *(const PG8_LAS bf16x8*)(lds + PG8_SA(b, h) + aoff + m * 2048 + k * 1024); } while (0)
#define PG8_LDB(dst, b, h) do { _Pragma("unroll") for (int n = 0; n < 2; ++n) _Pragma("unroll") for (int k = 0; k < 2; ++k) dst[n][k] = *(const PG8_LAS bf16x8*)(lds + PG8_SB(b, h) + boff + n * 2048 + k * 1024); } while (0)
#define PG8_MMA(ai, bj, At, Bt) do { __builtin_amdgcn_s_setprio(1); _Pragma("unroll") for (int m = 0; m < 4; ++m) _Pragma("unroll") for (int n = 0; n < 2; ++n) _Pragma("unroll") for (int k = 0; k < 2; ++k) \
        acc[ai][bj][m][n] = __builtin_amdgcn_mfma_f32_16x16x32_bf16(Bt[n][k], At[m][k], acc[ai][bj][m][n], 0, 0, 0); __builtin_amdgcn_s_setprio(0); } while (0)
#define PG8_WAIT_V(n) asm volatile("s_waitcnt vmcnt(" #n ")" ::: "memory")
#define PG8_WAIT_L(n) asm volatile("s_waitcnt lgkmcnt(" #n ")" ::: "memory")
#define PG8_BAR __builtin_amdgcn_s_barrier()
#define PG8_SCHED __builtin_amdgcn_sched_barrier(0)
    Unit cur, nxt; int ui = 0;
    if (!S.next(0, cur)) return;
    f32x4 acc[2][2][4][2];
#pragma unroll
    for (int a = 0; a < 2; ++a)
#pragma unroll
        for (int b = 0; b < 2; ++b)
#pragma unroll
            for (int m = 0; m < 4; ++m)
#pragma unroll
                for (int n = 0; n < 2; ++n) acc[a][b][m][n] = (f32x4){0.f, 0.f, 0.f, 0.f};
    bf16x8 At[4][2], B0[2][2], B1[2][2];
    const char* cA = (const char*)g.A + (size_t)cur.pm * tstep + (size_t)cur.k0 * kstep; const char* cB = (const char*)g.Bt + (size_t)cur.pn * tstep + (size_t)cur.k0 * kstep;
    S.a_ready(cur);
    if constexpr (SP2) {
        PG8_STAGE(PG8_SB(0, 0), cB, voffB); PG8_STAGE(PG8_SB(0, 1), cB + hstep, voffB); PG8_STAGE(PG8_SA(0, 0), cA, voffA); PG8_STAGE(PG8_SA(0, 1), cA + hstep, voffA);
        if (wr == 1) PG8_BAR;
        PG8_WAIT_V(2); PG8_BAR;
        PG8_STAGE(PG8_SB(1, 0), cB + kstep, voffB); PG8_STAGE(PG8_SA(1, 0), cA + kstep, voffA); PG8_STAGE(PG8_SB(1, 1), cB + hstep + kstep, voffB);
        PG8_WAIT_V(6); PG8_BAR;
    } else {
        PG8_STAGE(PG8_SB(0, 0), cB, voffB); PG8_STAGE(PG8_SA(0, 0), cA, voffA); PG8_STAGE(PG8_SB(0, 1), cB + hstep, voffB); PG8_STAGE(PG8_SA(0, 1), cA + hstep, voffA);
        if (wr == 1) PG8_BAR;
        PG8_WAIT_V(4); PG8_BAR;
        PG8_STAGE(PG8_SB(1, 0), cB + kstep, voffB); PG8_STAGE(PG8_SA(1, 0), cA + kstep, voffA); PG8_STAGE(PG8_SB(1, 1), cB + hstep + kstep, voffB);
        PG8_WAIT_V(6); PG8_BAR;
    }
    for (;;) {
        const bool has_next = S.next(ui + 1, nxt);
        const char* nA = has_next ? (const char*)g.A + (size_t)nxt.pm * tstep + (size_t)nxt.k0 * kstep : cA; const char* nB = has_next ? (const char*)g.Bt + (size_t)nxt.pn * tstep + (size_t)nxt.k0 * kstep : cB;
        const int nt = cur.nt;
        for (int t = 0; t < nt; t += 2) {
            const bool last = (t == nt - 2);
            const char* a1 = cA + (size_t)(t + 1) * kstep;
            const char* a2 = last ? nA : cA + (size_t)(t + 2) * kstep; const char* b2 = last ? nB : cB + (size_t)(t + 2) * kstep;
            const char* a3 = a2 + kstep; const char* b3 = b2 + kstep;
            if (last && has_next) S.a_ready(nxt);
            if constexpr (SP2) {
            PG8_LDB(B0, 0, 0); PG8_LDB(B1, 0, 1); PG8_SCHED; PG8_LDA(At, 0, 0); PG8_STAGE(PG8_SA(1, 1), a1 + hstep, voffA);
            PG8_WAIT_V(8); PG8_WAIT_L(0); PG8_BAR; PG8_MMA(0, 0, At, B0); PG8_MMA(0, 1, At, B1); PG8_BAR; PG8_SCHED;
            PG8_LDA(At, 0, 1); PG8_STAGE(PG8_SB(0, 0), b2, voffB); PG8_STAGE(PG8_SB(0, 1), b2 + hstep, voffB); PG8_STAGE(PG8_SA(0, 0), a2, voffA);
            PG8_WAIT_V(8); PG8_WAIT_L(0); PG8_BAR; PG8_MMA(1, 0, At, B0); PG8_MMA(1, 1, At, B1); PG8_BAR; PG8_SCHED;
            PG8_LDB(B0, 1, 0); PG8_LDB(B1, 1, 1); PG8_SCHED; PG8_LDA(At, 1, 0); PG8_STAGE(PG8_SA(0, 1), a2 + hstep, voffA);
            PG8_WAIT_V(8); PG8_WAIT_L(0); PG8_BAR; PG8_MMA(0, 0, At, B0); PG8_MMA(0, 1, At, B1); PG8_BAR; PG8_SCHED;
            PG8_LDA(At, 1, 1); PG8_STAGE(PG8_SB(1, 0), b3, voffB); PG8_STAGE(PG8_SB(1, 1), b3 + hstep, voffB); PG8_STAGE(PG8_SA(1, 0), a3, voffA);
            PG8_WAIT_V(8); PG8_WAIT_L(0); PG8_BAR; PG8_MMA(1, 0, At, B0); PG8_MMA(1, 1, At, B1); PG8_BAR; PG8_SCHED;
            } else {
            PG8_LDB(B0, 0, 0); PG8_SCHED; PG8_LDA(At, 0, 0); PG8_STAGE(PG8_SA(1, 1), a1 + hstep, voffA);
            PG8_WAIT_L(8); PG8_BAR; PG8_WAIT_L(0); PG8_MMA(0, 0, At, B0); PG8_BAR; PG8_SCHED;
            PG8_LDB(B1, 0, 1); PG8_STAGE(PG8_SB(0, 0), b2, voffB);
            PG8_BAR; PG8_WAIT_L(0); PG8_MMA(0, 1, At, B1); PG8_BAR;
            PG8_LDA(At, 0, 1); PG8_STAGE(PG8_SA(0, 0), a2, voffA);
            PG8_BAR; PG8_WAIT_L(0); PG8_MMA(1, 0, At, B0); PG8_BAR; PG8_SCHED;
            PG8_STAGE(PG8_SB(0, 1), b2 + hstep, voffB);
            PG8_WAIT_V(6); PG8_BAR; PG8_MMA(1, 1, At, B1); PG8_BAR;
            PG8_LDB(B0, 1, 0); PG8_SCHED; PG8_LDA(At, 1, 0); PG8_STAGE(PG8_SA(0, 1), a2 + hstep, voffA);
            PG8_WAIT_L(8); PG8_BAR; PG8_WAIT_L(0); PG8_MMA(0, 0, At, B0); PG8_BAR; PG8_SCHED;
            PG8_LDB(B1, 1, 1); PG8_STAGE(PG8_SB(1, 0), b3, voffB);
            PG8_BAR; PG8_WAIT_L(0); PG8_MMA(0, 1, At, B1); PG8_BAR;
            PG8_LDA(At, 1, 1); PG8_STAGE(PG8_SA(1, 0), a3, voffA);
            PG8_BAR; PG8_WAIT_L(0); PG8_MMA(1, 0, At, B0); PG8_BAR; PG8_SCHED;
            PG8_STAGE(PG8_SB(1, 1), b3 + hstep, voffB);
            PG8_WAIT_V(6); PG8_BAR; PG8_MMA(1, 1, At, B1); PG8_BAR;
            }
        }
        if constexpr (ALIGN_EPI) { if (wr == 0) PG8_BAR; }
        if constexpr (!Epi::AFTER_DRAIN) { E(acc, cur, wr, wc, fr, fq); S.done(cur); }
        if (!has_next) break;
#pragma unroll
        for (int a = 0; a < 2; ++a)
#pragma unroll
            for (int b = 0; b < 2; ++b)
#pragma unroll
                for (int m = 0; m < 4; ++m)
#pragma unroll
                    for (int n = 0; n < 2; ++n) acc[a][b][m][n] = (f32x4){0.f, 0.f, 0.f, 0.f};
        cur = nxt; cA = nA; cB = nB; ++ui;
        if constexpr (ALIGN_EPI) { if (wr == 1) PG8_BAR; }
    }
    PG8_WAIT_V(0);
    if constexpr (!ALIGN_EPI) { if (wr == 0) PG8_BAR; }
    PG8_BAR;
    if constexpr (Epi::AFTER_DRAIN) { E.fused(acc, cur, wr, wc, fr, fq, lds, wid, lane); S.done(cur); }
#undef PG8_SA
#undef PG8_SB
#undef PG8_STAGE
#undef PG8_LDA
#undef PG8_LDB
#undef PG8_MMA
#undef PG8_WAIT_V
#undef PG8_WAIT_L
#undef PG8_BAR
#undef PG8_SCHED
}
}

#ifndef REP_P0
#define REP_P0 1
#endif
#ifndef REP_G1
#define REP_G1 1
#endif
#ifndef REP_M1
#define REP_M1 1
#endif
#ifndef REP_M3
#define REP_M3 1
#endif
#ifndef REP_UP
#define REP_UP 1
#endif
#ifndef REP_ACT
#define REP_ACT 1
#endif
#ifndef REP_NRM
#define REP_NRM 1
#endif
#ifndef DEFER_STATE
#define DEFER_STATE 0
#endif
#ifndef REP_M1A
#define REP_M1A 1
#endif
#ifndef REP_M1S
#define REP_M1S 1
#endif
#ifndef REP_M1C
#define REP_M1C 1
#endif
#ifndef NT_EPI
#define NT_EPI 0
#endif
#if NT_EPI
#define EPI_ST(p, v) __builtin_nontemporal_store((v), (p))
#else
#define EPI_ST(p, v) (*(p) = (v))
#endif
#ifndef RUN_FIX
#define RUN_FIX 0
#endif
#ifndef P0_WG
#define P0_WG 1
#endif
using pg8::bf16_t; using pg8::bf16x8; using pg8::f32x4; using pg8::u32x4; using pg8::cvt_pk_bf16;
typedef unsigned u32x2 __attribute__((ext_vector_type(2)));
#define LAS __attribute__((address_space(3)))
constexpr int DM = 2048, SEQ = 2048, NBATCH = 4, MP = 8192, NS = 128, MREAL = 8320, MPAD = 8448;
constexpr int CONVD = 1024, NH = 4, DK = 128, DV = 256, QKD = 512, RANK = 16, DFF = 5632;
constexpr int INC = 6160, INP = 6400, UPN = 11264, PRW = 4096;
constexpr int NCH = 32, NTHR = 512;
constexpr float EPS = 1e-6f;
constexpr size_t O_YP = 0, O_YS = 16777216, O_CP = 17039360, O_GP = 17055744, O_FP = 18104320, O_CS = 18194432, O_GS = 18718720, O_FS = 52273152, O_TOTAL = 55156736;
constexpr size_t SZ_WIN = (size_t)INP * DM * 2, SZ_WOUT = (size_t)DM * DM * 2, SZ_WUP = (size_t)UPN * DM * 2, SZ_WDN = (size_t)DM * DFF * 2;
constexpr size_t WS_WIN = 0, WS_WOUT = WS_WIN + 2 * SZ_WIN, WS_WUP = WS_WOUT + 2 * SZ_WOUT, WS_WDN = WS_WUP + 2 * SZ_WUP;
constexpr size_t WS_XN = WS_WDN + 2 * SZ_WDN, WS_XR = WS_XN + (size_t)MPAD * DM * 2, WS_R = WS_XR + (size_t)MPAD * DM * 4;
constexpr size_t WS_PR = WS_R, WS_UC = WS_PR + (size_t)MPAD * PRW * 2, WS_GLR = WS_UC + (size_t)MPAD * CONVD * 4, WS_Y = WS_GLR + (size_t)MPAD * RANK * 4;
constexpr size_t WS_SU = WS_Y + (size_t)MPAD * DM * 2, WS_EB = WS_SU + (size_t)16 * NCH * DK * DV * 4, WS_QT = WS_EB + (size_t)16 * NCH * DK * 4, WS_AM = WS_QT + (size_t)MP * QKD * 2;
constexpr size_t WS_MIX_END = WS_AM + (size_t)512 * 4096 * 2;
constexpr size_t WS_H = WS_R, WS_FFN_END = WS_H + (size_t)MPAD * DFF * 2;
constexpr size_t WS_REND = WS_FFN_END > WS_MIX_END ? WS_FFN_END : WS_MIX_END;
constexpr int PRSW = 6400, NSP1 = 4;
constexpr size_t WS_PRS = WS_REND, WS_GLRP = WS_PRS + (size_t)8 * NS * PRSW * 4, WS_XSP = WS_GLRP + (size_t)8 * MPAD * RANK * 4, WS_END = WS_XSP + (size_t)11 * NS * DM * 4;
constexpr size_t WS_BAR = WS_END;
constexpr size_t WS_SS = WS_BAR + 16384, WS_SSP = WS_SS + (size_t)4 * MPAD * 4, WS_TAIL = WS_SSP + (size_t)MP * 32 * 4, WS_HEAD = WS_TAIL + (size_t)132 * 2 * DFF * 4, WS_TOTAL = WS_HEAD + (size_t)132 * 4 * DFF * 4;
constexpr int LDS_BYTES = 147456, LDS_BARST = LDS_BYTES - 64, LDS_HALO = 131072 + 2048;

__device__ __forceinline__ float bf_lo(unsigned w) { return __uint_as_float(w << 16); }
__device__ __forceinline__ float bf_hi(unsigned w) { return __uint_as_float(w & 0xffff0000u); }
__device__ __forceinline__ float bf1(bf16_t h) { return __uint_as_float((unsigned)h << 16); }
__device__ __forceinline__ bf16_t f2bf(float f) { return (bf16_t)(cvt_pk_bf16(f, 0.f) & 0xffffu); }
__device__ __forceinline__ float silu_f(float x) { return x * __builtin_amdgcn_rcpf(1.f + __expf(-x)); }
__device__ __forceinline__ float logsig_f(float z) { return fminf(z, 0.f) - __logf(1.f + __expf(-fabsf(z))); }
__device__ __forceinline__ float wave_sum(float v) {
#pragma unroll
    for (int o = 1; o < 64; o <<= 1) v += __shfl_xor(v, o);
    return v;
}
#define LDS_WAIT() asm volatile("s_waitcnt lgkmcnt(0)" ::: "memory")

__device__ __forceinline__ void tr_item(const float* W, int ldw, int ncols_valid, int K, bf16_t* WT, int dst_row0, int src_col0, bool perm, int kb, LAS float* scr, int lane, const float* gk = nullptr) {
    const int k0 = 64 * kb; const int c = src_col0 + (lane & 31); const bool ok = c < ncols_valid;
    float tv[32];
#pragma unroll
    for (int i = 0; i < 32; ++i) { const int kk = 2 * i + (lane >> 5); tv[i] = ok ? W[(size_t)(k0 + kk) * ldw + c] : 0.f; }
#pragma unroll
    for (int i = 0; i < 32; ++i) { const int kk = 2 * i + (lane >> 5); scr[kk * 33 + (lane & 31)] = gk ? tv[i] * gk[k0 + kk] : tv[i]; }
    LDS_WAIT(); asm volatile("" ::: "memory");
    const int c8 = lane & 7;
#pragma unroll
    for (int j = 0; j < 4; ++j) { const int n = (lane >> 3) + 8 * j; const int sc = perm ? pg8::perm32(n) : n; const LAS float* s = scr + (8 * c8) * 33 + sc;
        u32x4 o; o.x = cvt_pk_bf16(s[0 * 33], s[1 * 33]); o.y = cvt_pk_bf16(s[2 * 33], s[3 * 33]); o.z = cvt_pk_bf16(s[4 * 33], s[5 * 33]); o.w = cvt_pk_bf16(s[6 * 33], s[7 * 33]);
        *(u32x4*)(WT + (size_t)(dst_row0 + n) * K + k0 + 8 * c8) = o; }
    LDS_WAIT(); asm volatile("" ::: "memory");
}
__device__ __forceinline__ void win_map(int g, int& src, int& nvalid, bool& perm) {
    const int tile = g >> 3, gi = g & 7; nvalid = INC;
    if (tile < 8) { perm = false; src = (gi < 4) ? (1024 + 128 * tile + 32 * gi) : (2048 + 128 * tile + 32 * (gi - 4)); }
    else if (tile < 12) { perm = true; src = 256 * (tile - 8) + 32 * gi; }
    else if (tile < 24) { perm = true; src = 3072 + 256 * (tile - 12) + 32 * gi; }
    else { perm = false; src = 6144; if (gi != 0) nvalid = 0; }
}
struct P0Desc { const float* src; size_t ldw; const float* gk; bf16_t* dst; int K; bool ok, perm; };
constexpr int P0_I_IN = 25 * 32, P0_I_OUT = 8 * 32, P0_I_UP = 44 * 32, P0_I_DN = 8 * 88, P0_I_L = P0_I_IN + P0_I_OUT + P0_I_UP + P0_I_DN;
struct P0Src { const float *w_in, *w_out, *w_up, *w_down, *g_mix, *g_ffn; bf16_t *WT_IN, *WT_OUT, *WT_UP, *WT_DN; };
__device__ __forceinline__ bool p0_decode(int it, const P0Src& t, int wid, int lane, P0Desc& d) {
    if (it >= 2 * P0_I_L) return false;
    const int l = it / P0_I_L; int rr = it - l * P0_I_L; const float* W; int ldw, nv, K, blk, kb, dg; bf16_t* WT; bool perm; const float* gk = nullptr;
    if (rr < P0_I_IN) { blk = rr >> 5; kb = rr & 31; const int sg = blk * 8 + wid; W = t.w_in + (size_t)l * DM * INC; ldw = INC; nv = INC; K = DM; WT = t.WT_IN + (size_t)l * INP * DM; gk = t.g_mix + (size_t)l * DM;
        if (sg < 32) { dg = 64 + sg; perm = true; } else if (sg < 64) { const int q = sg - 32; dg = (q >> 2) * 8 + (q & 3); perm = true; } else if (sg < 96) { const int q = sg - 64; dg = (q >> 2) * 8 + 4 + (q & 3); perm = true; }
        else { dg = sg; perm = sg < 192; } }
    else if ((rr -= P0_I_IN) < P0_I_OUT) { blk = rr >> 5; kb = rr & 31; dg = blk * 8 + wid; perm = true; W = t.w_out + (size_t)l * DM * DM; ldw = DM; nv = DM; K = DM; WT = t.WT_OUT + (size_t)l * DM * DM; }
    else if ((rr -= P0_I_OUT) < P0_I_UP) { blk = rr >> 5; kb = rr & 31; const int sg = blk * 8 + wid; perm = true; W = t.w_up + (size_t)l * DM * UPN; ldw = UPN; nv = UPN; K = DM; WT = t.WT_UP + (size_t)l * UPN * DM; gk = t.g_ffn + (size_t)l * DM;
        if (sg < 176) dg = (sg >> 2) * 8 + (sg & 3); else { const int q = sg - 176; dg = (q >> 2) * 8 + 4 + (q & 3); } }
    else { rr -= P0_I_UP; blk = rr / 88; kb = rr - blk * 88; dg = blk * 8 + wid; perm = true; W = t.w_down + (size_t)l * DFF * DM; ldw = DM; nv = DM; K = DFF; WT = t.WT_DN + (size_t)l * DM * DFF; }
    const int k0 = 64 * kb, c = blk * 256 + 4 * lane;
    d.ok = c < nv; d.src = W + (size_t)(k0 + wid * 8) * ldw + c; d.ldw = (size_t)ldw; d.gk = gk ? gk + k0 + wid * 8 : nullptr; d.dst = WT + (size_t)(dg * 32) * K + k0; d.K = K; d.perm = perm; return true;
}
__device__ __forceinline__ void p0_load(const P0Desc& d, f32x4 (&tv)[8]) {
#pragma unroll
    for (int i = 0; i < 8; ++i) tv[i] = d.ok ? *(const f32x4*)(d.src + (size_t)i * d.ldw) : (f32x4){0.f, 0.f, 0.f, 0.f};
}
__device__ __forceinline__ void p0_to_lds(const P0Desc& d, const f32x4 (&tv)[8], LAS float* T, int wid, int lane) {
#pragma unroll
    for (int i = 0; i < 8; ++i) { const float g = d.gk ? d.gk[i] : 1.f; LAS float* tp = T + (wid * 8 + i) * 257 + 4 * lane; tp[0] = tv[i].x * g; tp[1] = tv[i].y * g; tp[2] = tv[i].z * g; tp[3] = tv[i].w * g; }
}
__device__ __forceinline__ void p0_out(const P0Desc& d, const LAS float* T, int wid, int lane) {
    const int c8 = lane & 7;
#pragma unroll
    for (int j = 0; j < 4; ++j) { const int n = (lane >> 3) + 8 * j; const int sc = d.perm ? pg8::perm32(n) : n; const LAS float* sp = T + (8 * c8) * 257 + 32 * wid + sc;
        u32x4 o; o.x = cvt_pk_bf16(sp[0 * 257], sp[1 * 257]); o.y = cvt_pk_bf16(sp[2 * 257], sp[3 * 257]); o.z = cvt_pk_bf16(sp[4 * 257], sp[5 * 257]); o.w = cvt_pk_bf16(sp[6 * 257], sp[7 * 257]);
        *(u32x4*)(d.dst + (size_t)n * d.K + 8 * c8) = o; }
}
__device__ __forceinline__ void rms_row_bf16(const float* xrow, const float* g, bf16_t* orow, int lane) {
    const f32x4* xr = (const f32x4*)xrow + lane; f32x4 v[8]; float s = 0.f;
#pragma unroll
    for (int j = 0; j < 8; ++j) { v[j] = xr[64 * j]; s += (v[j].x * v[j].x + v[j].y * v[j].y) + (v[j].z * v[j].z + v[j].w * v[j].w); }
    const float rstd = rsqrtf(wave_sum(s) * (1.f / DM) + EPS);
    const f32x4* gr = (const f32x4*)g + lane; u32x2* o8 = (u32x2*)orow + lane;
#pragma unroll
    for (int j = 0; j < 8; ++j) { const f32x4 gg = gr[64 * j]; u32x2 w; w.x = cvt_pk_bf16(v[j].x * rstd * gg.x, v[j].y * rstd * gg.y); w.y = cvt_pk_bf16(v[j].z * rstd * gg.z, v[j].w * rstd * gg.w); o8[64 * j] = w; }
}
__device__ __forceinline__ void row_bf16_ss(const float* xrow, bf16_t* orow, float* ss, int lane) {
    const f32x4* xr = (const f32x4*)xrow + lane; f32x4 v[8]; float s = 0.f;
#pragma unroll
    for (int j = 0; j < 8; ++j) { v[j] = xr[64 * j]; s += (v[j].x * v[j].x + v[j].y * v[j].y) + (v[j].z * v[j].z + v[j].w * v[j].w); }
    s = wave_sum(s); u32x2* o8 = (u32x2*)orow + lane;
#pragma unroll
    for (int j = 0; j < 8; ++j) { u32x2 w; w.x = cvt_pk_bf16(v[j].x, v[j].y); w.y = cvt_pk_bf16(v[j].z, v[j].w); o8[64 * j] = w; }
    if (lane == 0) *ss = s;
}
__device__ __forceinline__ void rms_row2_bf16(const float* xa, const float* xb, const float* g, bf16_t* oa, bf16_t* ob, int lane) {
    const f32x4* ra = (const f32x4*)xa + lane; const f32x4* rb = (const f32x4*)xb + lane; f32x4 va[8], vb[8]; float sa = 0.f, sb = 0.f;
#pragma unroll
    for (int j = 0; j < 8; ++j) { va[j] = ra[64 * j]; vb[j] = rb[64 * j]; }
#pragma unroll
    for (int j = 0; j < 8; ++j) { sa += (va[j].x * va[j].x + va[j].y * va[j].y) + (va[j].z * va[j].z + va[j].w * va[j].w); sb += (vb[j].x * vb[j].x + vb[j].y * vb[j].y) + (vb[j].z * vb[j].z + vb[j].w * vb[j].w); }
    const float rsa = rsqrtf(wave_sum(sa) * (1.f / DM) + EPS), rsb = rsqrtf(wave_sum(sb) * (1.f / DM) + EPS);
    const f32x4* gr = (const f32x4*)g + lane; u32x2* pa = (u32x2*)oa + lane; u32x2* pb = (u32x2*)ob + lane;
#pragma unroll
    for (int j = 0; j < 8; ++j) { const f32x4 gg = gr[64 * j]; u32x2 w;
        w.x = cvt_pk_bf16(va[j].x * rsa * gg.x, va[j].y * rsa * gg.y); w.y = cvt_pk_bf16(va[j].z * rsa * gg.z, va[j].w * rsa * gg.w); pa[64 * j] = w;
        w.x = cvt_pk_bf16(vb[j].x * rsb * gg.x, vb[j].y * rsb * gg.y); w.y = cvt_pk_bf16(vb[j].z * rsb * gg.z, vb[j].w * rsb * gg.w); pb[64 * j] = w; }
}
__device__ __forceinline__ void rms_row_f32(const float* xrow, const float* g, float* orow, int lane) {
    const f32x4* xr = (const f32x4*)xrow + lane; f32x4 v[8]; float s = 0.f;
#pragma unroll
    for (int j = 0; j < 8; ++j) { v[j] = xr[64 * j]; s += (v[j].x * v[j].x + v[j].y * v[j].y) + (v[j].z * v[j].z + v[j].w * v[j].w); }
    const float rstd = rsqrtf(wave_sum(s) * (1.f / DM) + EPS);
    const f32x4* gr = (const f32x4*)g + lane; f32x4* o = (f32x4*)orow + lane;
#pragma unroll
    for (int j = 0; j < 8; ++j) { const f32x4 gg = gr[64 * j]; o[64 * j] = v[j] * rstd * gg; }
}

struct EpiIn {
    static constexpr bool PERM = false, AFTER_DRAIN = false;
    bf16_t* PR; float* UC; float* GLRP; float* PRS; const float* SS; float* conv_p;
    __device__ __forceinline__ void operator()(const f32x4 (&acc)[2][2][4][2], const pg8::Unit& u, int wr, int wc, int fr, int fq) const {
        asm volatile("" : "+v"(fr), "+v"(fq), "+s"(wr), "+s"(wc));
        const int row0 = u.pm * 256 + wr * 64 + fr;
        float rs[2][4];
#pragma unroll
        for (int ai = 0; ai < 2; ++ai)
#pragma unroll
            for (int m = 0; m < 4; ++m) rs[ai][m] = rsqrtf(SS[row0 + ai * 128 + m * 16] * (1.f / DM) + EPS);
        if (u.pn == 24) {
            if (wc == 0) {
#pragma unroll
                for (int ai = 0; ai < 2; ++ai)
#pragma unroll
                    for (int m = 0; m < 4; ++m) *(f32x4*)(GLRP + ((size_t)u.sp * MPAD + row0 + ai * 128 + m * 16) * RANK + 4 * fq) = acc[ai][0][m][0] * rs[ai][m];
            }
        } else if (u.sp >= 0) {
            float* rp0 = PRS + ((size_t)u.sp * NS + wr * 64 + fr) * PRSW;
            if (u.pn < 8) {
#pragma unroll
                for (int m = 0; m < 4; ++m) { float* rp = rp0 + (size_t)(m * 16) * PRSW + 1024 + u.pn * 128 + wc * 32 + 8 * fq;
#pragma unroll
                    for (int bj = 0; bj < 2; ++bj)
#pragma unroll
                        for (int n = 0; n < 2; ++n) *(f32x4*)(rp + bj * 1024 + 4 * n) = acc[0][bj][m][n] * rs[0][m]; }
            } else { const int cb = (u.pn < 12 ? 256 * (u.pn - 8) : 3072 + 256 * (u.pn - 12)) + wc * 32 + 8 * fq;
#pragma unroll
                for (int m = 0; m < 4; ++m) { float* rp = rp0 + (size_t)(m * 16) * PRSW + cb;
#pragma unroll
                    for (int bj = 0; bj < 2; ++bj)
#pragma unroll
                        for (int n = 0; n < 2; ++n) *(f32x4*)(rp + bj * 128 + 4 * n) = acc[0][bj][m][n] * rs[0][m]; }
            }
        } else if (u.pn < 8) {
#pragma unroll
            for (int ai = 0; ai < 2; ++ai)
#pragma unroll
                for (int m = 0; m < 4; ++m) { const int row = row0 + ai * 128 + m * 16, cc = u.pn * 128 + wc * 32 + 8 * fq; bf16_t* rp = (bf16_t*)UC + (size_t)row * CONVD + cc; const float r2 = rs[ai][m] * rs[ai][m]; const int p = row & (SEQ - 1);
                    const f32x4 u0 = acc[ai][0][m][0] * acc[ai][1][m][0] * r2, u1 = acc[ai][0][m][1] * acc[ai][1][m][1] * r2; u32x4 w;
                    w.x = cvt_pk_bf16(u0.x, u0.y); w.y = cvt_pk_bf16(u0.z, u0.w); w.z = cvt_pk_bf16(u1.x, u1.y); w.w = cvt_pk_bf16(u1.z, u1.w); EPI_ST((u32x4*)rp, w);
                    if (p >= SEQ - 2) { float* sp = conv_p + ((size_t)(row >> 11) * 2 + (p - (SEQ - 2))) * CONVD + cc; *(f32x4*)sp = u0; *(f32x4*)(sp + 4) = u1; } }
        } else {
#pragma unroll
            for (int ai = 0; ai < 2; ++ai)
#pragma unroll
                for (int m = 0; m < 4; ++m) { bf16_t* rp = PR + (size_t)(row0 + ai * 128 + m * 16) * PRW + (u.pn - 8) * 256 + wc * 32 + 8 * fq; const float r1 = rs[ai][m];
#pragma unroll
                    for (int bj = 0; bj < 2; ++bj) { const f32x4 v0 = acc[ai][bj][m][0] * r1, v1 = acc[ai][bj][m][1] * r1; u32x4 w;
                        w.x = cvt_pk_bf16(v0[0], v0[1]); w.y = cvt_pk_bf16(v0[2], v0[3]); w.z = cvt_pk_bf16(v1[0], v1[1]); w.w = cvt_pk_bf16(v1[2], v1[3]);
                        EPI_ST((u32x4*)(rp + bj * 128), w); } }
        }
    }
};
template <int N> __device__ __forceinline__ float ror16(float v) { return __int_as_float(__builtin_amdgcn_update_dpp(0, __float_as_int(v), 0x120 + N, 0xF, 0xF, false)); }
struct EpiUp {
    static constexpr bool PERM = false, AFTER_DRAIN = false;
    bf16_t* H; const float* cw; const float* cb; float* TAIL; float* HEAD; const float* st_in; float* ffn_p; float* ffn_s; LAS float* halo; const float* SS;
    __device__ __forceinline__ void operator()(const f32x4 (&acc)[2][2][4][2], const pg8::Unit& u, int wr, int wc, int fr, int fq) const {
        asm volatile("" : "+v"(fr), "+v"(fq), "+s"(wr), "+s"(wc));
        const int col = u.pn * 128 + wc * 32 + 8 * fq; const int lc = wc * 32 + 8 * fq;
        if (u.pm == 32) {
            if (!RUN_FIX) __builtin_amdgcn_s_barrier();
#pragma unroll
            for (int n = 0; n < 2; ++n) { const int cn = col + 4 * n;
                const f32x4 w0 = *(const f32x4*)(cw + cn), w1 = *(const f32x4*)(cw + DFF + cn), w2 = *(const f32x4*)(cw + 2 * DFF + cn), bb = *(const f32x4*)(cb + cn);
#pragma unroll
                for (int m = 0; m < 4; ++m) { const int s = wr * 64 + m * 16 + fr; const float* sp = st_in + (size_t)s * 2 * DFF + cn; float* op = ffn_s + (size_t)s * 2 * DFF + cn;
                    const float r1 = rsqrtf(SS[MP + s] * (1.f / DM) + EPS);
                    const f32x4 s0 = *(const f32x4*)sp, s1 = *(const f32x4*)(sp + DFF), uu = acc[0][0][m][n] * r1, vv = acc[0][1][m][n] * r1;
                    *(f32x4*)op = s1; *(f32x4*)(op + DFF) = uu;
                    const f32x4 cu = s0 * w0 + s1 * w1 + uu * w2 + bb; u32x2 hw;
                    hw.x = cvt_pk_bf16(silu_f(cu[0]) * vv[0], silu_f(cu[1]) * vv[1]); hw.y = cvt_pk_bf16(silu_f(cu[2]) * vv[2], silu_f(cu[3]) * vv[3]);
                    *(u32x2*)(H + (size_t)(MP + s) * DFF + cn) = hw; *(u32x2*)(H + (size_t)(MP + 128 + s) * DFF + cn) = (u32x2){0u, 0u}; }
                asm volatile("" ::: "memory"); }
            return;
        }
        const int row0 = u.pm * 256 + wr * 64 + fr;
        float rs[2][4];
#pragma unroll
        for (int ai = 0; ai < 2; ++ai)
#pragma unroll
            for (int m = 0; m < 4; ++m) rs[ai][m] = rsqrtf(SS[row0 + ai * 128 + m * 16] * (1.f / DM) + EPS);
        if (!RUN_FIX) {
        if (fr >= 14) {
#pragma unroll
            for (int ai = 0; ai < 2; ++ai)
#pragma unroll
                for (int n = 0; n < 2; ++n) *(LAS f32x4*)(halo + ((2 * ai + wr) * 2 + (fr - 14)) * 128 + lc + 4 * n) = acc[ai][0][3][n] * rs[ai][3];
        }
        asm volatile("s_waitcnt lgkmcnt(0)" ::: "memory"); __builtin_amdgcn_s_barrier(); asm volatile("" ::: "memory");
        }
        u32x2 hkeep[2][4];
#pragma unroll
        for (int n = 0; n < 2; ++n) { const int cn = col + 4 * n;
            const f32x4 w0 = *(const f32x4*)(cw + cn), w1 = *(const f32x4*)(cw + DFF + cn), w2 = *(const f32x4*)(cw + 2 * DFF + cn), bb = *(const f32x4*)(cb + cn);
#pragma unroll
            for (int ai = 0; ai < 2; ++ai) {
                const int rho = 2 * ai + wr; const f32x4 z = {0.f, 0.f, 0.f, 0.f};
                const f32x4 h0 = (!RUN_FIX && rho > 0) ? *(const LAS f32x4*)(halo + ((rho - 1) * 2 + 0) * 128 + lc + 4 * n) : z, h1 = (!RUN_FIX && rho > 0) ? *(const LAS f32x4*)(halo + ((rho - 1) * 2 + 1) * 128 + lc + 4 * n) : z;
                f32x4 pu = {0.f, 0.f, 0.f, 0.f};
#pragma unroll
                for (int m = 0; m < 4; ++m) { const f32x4 uu = acc[ai][0][m][n] * rs[ai][m], vv = acc[ai][1][m][n] * rs[ai][m]; f32x4 p1, p2;
#pragma unroll
                    for (int e = 0; e < 4; ++e) { const float c1 = ror16<1>(uu[e]), c2 = ror16<2>(uu[e]); float q1, q2;
                        if (m > 0) { q1 = ror16<1>(pu[e]); q2 = ror16<2>(pu[e]); }
                        else { q1 = h1[e]; q2 = fr == 1 ? h1[e] : h0[e]; }
                        p1[e] = fr >= 1 ? c1 : q1; p2[e] = fr >= 2 ? c2 : q2; }
                    const f32x4 cu = p2 * w0 + p1 * w1 + uu * w2 + bb; u32x2 hw;
                    hw.x = cvt_pk_bf16(silu_f(cu[0]) * vv[0], silu_f(cu[1]) * vv[1]); hw.y = cvt_pk_bf16(silu_f(cu[2]) * vv[2], silu_f(cu[3]) * vv[3]);
                    if (n == 0) hkeep[ai][m] = hw; else { u32x4 h4; h4.x = hkeep[ai][m].x; h4.y = hkeep[ai][m].y; h4.z = hw.x; h4.w = hw.y; EPI_ST((u32x4*)(H + (size_t)(row0 + ai * 128 + m * 16) * DFF + col), h4); } pu = uu;
                    if (RUN_FIX) { const int R = u.pm * 4 + rho;
                        if (m == 3 && fr >= 14) { *(f32x4*)(TAIL + ((size_t)R * 2 + (fr - 14)) * DFF + cn) = uu; if ((R & 31) == 31) *(f32x4*)(ffn_p + ((size_t)(R >> 5) * 2 + (fr - 14)) * DFF + cn) = uu; }
                        if (m == 0 && fr < 2) { float* hp = HEAD + ((size_t)R * 2 + fr) * 2 * DFF + cn; *(f32x4*)hp = uu; *(f32x4*)(hp + DFF) = vv; } } }
            }
            asm volatile("" ::: "memory"); }
        if (!RUN_FIX && wr == 1 && fr >= 14) {
            const f32x4 t0 = acc[1][0][3][0] * rs[1][3], t1 = acc[1][0][3][1] * rs[1][3];
            float* tp = TAIL + ((size_t)u.pm * 2 + (fr - 14)) * DFF + col; *(f32x4*)tp = t0; *(f32x4*)(tp + 4) = t1;
            if ((u.pm & 7) == 7) { float* sp = ffn_p + ((size_t)(u.pm >> 3) * 2 + (fr - 14)) * DFF + col; *(f32x4*)sp = t0; *(f32x4*)(sp + 4) = t1; }
        }
        if (!RUN_FIX && wr == 0 && fr < 2) {
            float* hp = HEAD + ((size_t)u.pm * 2 + fr) * 2 * DFF + col; const float r1 = rs[0][0]; *(f32x4*)hp = acc[0][0][0][0] * r1; *(f32x4*)(hp + 4) = acc[0][0][0][1] * r1; *(f32x4*)(hp + DFF) = acc[0][1][0][0] * r1; *(f32x4*)(hp + DFF + 4) = acc[0][1][0][1] * r1;
        }
    }
};
struct EpiRes {
    static constexpr bool PERM = false, AFTER_DRAIN = false;
    const float* baseP; float* out; float* XSP; bf16_t* XB; float* SS;
    __device__ __forceinline__ void operator()(const f32x4 (&acc)[2][2][4][2], const pg8::Unit& u, int wr, int wc, int fr, int fq) const {
        asm volatile("" : "+v"(fr), "+v"(fq), "+s"(wr), "+s"(wc));
        const int row0 = u.pm * 256 + wr * 64 + fr; const int col0 = u.pn * 256 + wc * 32 + 8 * fq;
        if (u.sp >= 0) {
#pragma unroll
            for (int m = 0; m < 4; ++m) { float* op = XSP + ((size_t)u.sp * NS + wr * 64 + m * 16 + fr) * DM + col0;
#pragma unroll
                for (int bj = 0; bj < 2; ++bj)
#pragma unroll
                    for (int n = 0; n < 2; ++n) *(f32x4*)(op + bj * 128 + 4 * n) = acc[0][bj][m][n]; }
            return;
        }
#pragma unroll
        for (int ai = 0; ai < 2; ++ai)
#pragma unroll
            for (int m = 0; m < 4; ++m) { const int row = row0 + ai * 128 + m * 16;
                { bf16_t* xb = XB + (size_t)row * DM + col0; float ss = 0.f;
#pragma unroll
                    for (int bj = 0; bj < 2; ++bj) { f32x4 b0, b1;
                        if (baseP) { const float* bp = baseP + (size_t)row * DM + col0 + bj * 128; b0 = *(const f32x4*)bp; b1 = *(const f32x4*)(bp + 4); }
                        else { const u32x4 bw = *(const u32x4*)(xb + bj * 128); b0 = (f32x4){bf_lo(bw.x), bf_hi(bw.x), bf_lo(bw.y), bf_hi(bw.y)}; b1 = (f32x4){bf_lo(bw.z), bf_hi(bw.z), bf_lo(bw.w), bf_hi(bw.w)}; }
                        const f32x4 v0 = b0 + acc[ai][bj][m][0], v1 = b1 + acc[ai][bj][m][1];
                        ss += ((v0.x * v0.x + v0.y * v0.y) + (v0.z * v0.z + v0.w * v0.w)) + ((v1.x * v1.x + v1.y * v1.y) + (v1.z * v1.z + v1.w * v1.w));
                        u32x4 w; w.x = cvt_pk_bf16(v0.x, v0.y); w.y = cvt_pk_bf16(v0.z, v0.w); w.z = cvt_pk_bf16(v1.x, v1.y); w.w = cvt_pk_bf16(v1.z, v1.w); EPI_ST((u32x4*)(xb + bj * 128), w); }
                    if (SS) { ss += __shfl_xor(ss, 16); ss += __shfl_xor(ss, 32); if (fq == 0) SS[(size_t)row * 32 + u.pn * 4 + wc] = ss; } }
                asm volatile("" ::: "memory"); }
    }
};

#define MFMA16(x, y, c) __builtin_amdgcn_mfma_f32_16x16x32_bf16((x), (y), (c), 0, 0, 0)
typedef short s16x4 __attribute__((ext_vector_type(4)));
template <int RS> __device__ __forceinline__ bf16x8 tr_frag(const LAS bf16_t* T, int c, int ks, int lane) {
#ifdef TR_GATHER
    const int g = lane >> 4; const LAS bf16_t* a0 = T + (32 * ks + 8 * g) * RS + 16 * c + (lane & 15); bf16x8 o;
#pragma unroll
    for (int j = 0; j < 8; ++j) o[j] = (short)a0[j * RS];
    return o;
#else
    const int g = lane >> 4, qq = (lane & 15) >> 2, p = lane & 3; const LAS bf16_t* a0 = T + (32 * ks + 8 * g + qq) * RS + 16 * c + 4 * p;
    unsigned addr = (unsigned)(size_t)a0; asm volatile("" : "+v"(addr));
    const LAS bf16_t* a1 = (const LAS bf16_t*)(size_t)addr;
    s16x4 t0 = __builtin_amdgcn_ds_read_tr16_b64_v4i16((LAS s16x4*)a1), t1 = __builtin_amdgcn_ds_read_tr16_b64_v4i16((LAS s16x4*)(a1 + 4 * RS));
    asm volatile("" : "+v"(t0), "+v"(t1) : "v"(addr));
    return __builtin_shufflevector(t0, t1, 0, 1, 2, 3, 4, 5, 6, 7);
#endif
}
__device__ __forceinline__ void stage_v(LAS bf16_t* Vn, const bf16_t* PR, int tok0, int h, int tid) {
#pragma unroll
    for (int i = 0; i < 4; ++i) { const int id = tid + 512 * i, j = id >> 5, cc = id & 31; *(LAS u32x4*)(Vn + j * 272 + cc * 8) = *(const u32x4*)(PR + (size_t)(tok0 + j) * PRW + 2048 + h * DV + cc * 8); }
}
__device__ __forceinline__ void gla_passA(LAS unsigned char* lds, int uidx, const bf16_t* PR, const float* GLRP, const float* w2, const float* gb,
                                          bf16_t* SUB, float* EB, bf16_t* QT, bf16_t* AM, int tid, int wid, int lane) {
    const int b = uidx >> 7, c = (uidx >> 2) & 31, h = uidx & 3; const int tok0 = b * SEQ + c * 64; const int bh = b * 4 + h;
    LAS float* Bc = (LAS float*)lds;
    LAS float* bCs = Bc + 64 * 129;
    LAS bf16_t* Qs = (LAS bf16_t*)(lds + 33536);
    LAS bf16_t* Ks = Qs + 64 * 136;
    LAS bf16_t* Kh = Ks + 64 * 136;
    LAS bf16_t* Vn = Kh + 64 * 136;
    const int r = lane & 15, q = lane >> 4;
    const bf16_t* qp = PR + (size_t)(tok0 + (tid >> 3)) * PRW + 1024 + h * DK + (tid & 7) * 16;
    const u32x4 qa = *(const u32x4*)qp, qb = *(const u32x4*)(qp + 8), ka = *(const u32x4*)(qp + 512), kb = *(const u32x4*)(qp + 520);
    u32x4 vreg[4];
#pragma unroll
    for (int i = 0; i < 4; ++i) { const int id = tid + 512 * i; vreg[i] = *(const u32x4*)(PR + (size_t)(tok0 + (id >> 5)) * PRW + 2048 + h * DV + (id & 31) * 8); }
    LAS float* Gs = (LAS float*)(lds + 120576);
    LAS float* Tt = Gs + 64 * 16;
    if (tid < 256) { const int t = tid >> 2, r4 = (tid & 3) * 4; const float* gp = GLRP + (size_t)(tok0 + t) * RANK + r4; f32x4 g = *(const f32x4*)gp;
#pragma unroll
        for (int sp = 1; sp < NSP1; ++sp) g += *(const f32x4*)(gp + (size_t)sp * MPAD * RANK);
        *(LAS f32x4*)(Gs + t * 16 + r4) = g; }
    const int kcol = tid & 127, tg = tid >> 7;
    float wk[16];
#pragma unroll
    for (int rr = 0; rr < 16; ++rr) wk[rr] = w2[rr * QKD + h * DK + kcol];
    const float bias = gb[h * DK + kcol];
#pragma unroll
    for (int i = 0; i < 4; ++i) { const int id = tid + 512 * i; *(LAS u32x4*)(Vn + (id >> 5) * 272 + (id & 31) * 8) = vreg[i]; }
    __syncthreads();
    { float run = 0.f;
#pragma unroll 4
      for (int i = 0; i < 16; ++i) { const int t = 16 * tg + i; const LAS f32x4* gr = (const LAS f32x4*)(Gs + t * 16); const f32x4 a0 = gr[0], a1 = gr[1], a2 = gr[2], a3 = gr[3];
          float z = bias;
          z += a0.x * wk[0] + a0.y * wk[1] + a0.z * wk[2] + a0.w * wk[3]; z += a1.x * wk[4] + a1.y * wk[5] + a1.z * wk[6] + a1.w * wk[7];
          z += a2.x * wk[8] + a2.y * wk[9] + a2.z * wk[10] + a2.w * wk[11]; z += a3.x * wk[12] + a3.y * wk[13] + a3.z * wk[14] + a3.w * wk[15];
          run += logsig_f(z) * (1.f / 16.f); Bc[t * 129 + kcol] = run; }
      Tt[tg * 128 + kcol] = run; }
    __syncthreads();
    {
        const int j = tid >> 3, kr = (tid & 7) * 16, jg = j >> 4;
        const float scale = 0.08838834764831845f;
        u32x4 oq[2], ok[2], oh[2];
#pragma unroll
        for (int e4 = 0; e4 < 4; ++e4) {
            const f32x4 t0 = *(const LAS f32x4*)(Tt + 0 * 128 + kr + 4 * e4), t1 = *(const LAS f32x4*)(Tt + 1 * 128 + kr + 4 * e4), t2 = *(const LAS f32x4*)(Tt + 2 * 128 + kr + 4 * e4), t3 = *(const LAS f32x4*)(Tt + 3 * 128 + kr + 4 * e4);
            const f32x4 zz = {0.f, 0.f, 0.f, 0.f}; const f32x4 off = (jg > 0 ? t0 : zz) + (jg > 1 ? t1 : zz) + (jg > 2 ? t2 : zz), bc = (t0 + t1) + (t2 + t3);
#pragma unroll
            for (int eh = 0; eh < 2; ++eh) { const int e2 = 2 * e4 + eh; const unsigned qw = e2 < 4 ? qa[e2] : qb[e2 - 4], kw = e2 < 4 ? ka[e2] : kb[e2 - 4];
                const int k = kr + 2 * e2;
                const float b0 = Bc[j * 129 + k] + off[2 * eh], b1 = Bc[j * 129 + k + 1] + off[2 * eh + 1], c0 = bc[2 * eh], c1 = bc[2 * eh + 1];
                const float q0 = bf_lo(qw) * scale * __expf(b0), q1 = bf_hi(qw) * scale * __expf(b1);
                const float k0 = bf_lo(kw), k1 = bf_hi(kw);
                const unsigned pq = cvt_pk_bf16(q0, q1), pk = cvt_pk_bf16(k0 * __expf(-b0), k1 * __expf(-b1)), ph = cvt_pk_bf16(k0 * __expf(c0 - b0), k1 * __expf(c1 - b1));
                if (e2 < 4) { oq[0][e2] = pq; ok[0][e2] = pk; oh[0][e2] = ph; } else { oq[1][e2 - 4] = pq; ok[1][e2 - 4] = pk; oh[1][e2 - 4] = ph; } }
        }
        *(LAS u32x4*)(Qs + j * 136 + kr) = oq[0]; *(LAS u32x4*)(Qs + j * 136 + kr + 8) = oq[1];
        *(LAS u32x4*)(Ks + j * 136 + kr) = ok[0]; *(LAS u32x4*)(Ks + j * 136 + kr + 8) = ok[1];
        *(LAS u32x4*)(Kh + j * 136 + kr) = oh[0]; *(LAS u32x4*)(Kh + j * 136 + kr + 8) = oh[1];
        bf16_t* qt = QT + (size_t)(tok0 + j) * QKD + h * DK + kr; *(u32x4*)qt = oq[0]; *(u32x4*)(qt + 8) = oq[1];
        if (tid < DK) EB[((size_t)bh * NCH + c) * DK + tid] = __expf((Tt[tid] + Tt[128 + tid]) + (Tt[256 + tid] + Tt[384 + tid]));
    }
    __syncthreads();
    {
        const int it = wid >> 1, jt0 = (wid & 1) * 2; f32x4 a[2] = {{0.f, 0.f, 0.f, 0.f}, {0.f, 0.f, 0.f, 0.f}};
#pragma unroll
        for (int ks = 0; ks < 4; ++ks) { const bf16x8 y = *(const LAS bf16x8*)(Qs + (16 * it + r) * 136 + 32 * ks + 8 * q);
#pragma unroll
            for (int jj = 0; jj < 2; ++jj) { const bf16x8 x = *(const LAS bf16x8*)(Ks + (16 * (jt0 + jj) + r) * 136 + 32 * ks + 8 * q); a[jj] = MFMA16(x, y, a[jj]); } }
        const int i = 16 * it + r;
#pragma unroll
        for (int jj = 0; jj < 2; ++jj) { const int jb = 16 * (jt0 + jj) + 4 * q; u32x2 w;
            w.x = cvt_pk_bf16(jb + 0 <= i ? a[jj][0] : 0.f, jb + 1 <= i ? a[jj][1] : 0.f); w.y = cvt_pk_bf16(jb + 2 <= i ? a[jj][2] : 0.f, jb + 3 <= i ? a[jj][3] : 0.f);
            *(u32x2*)(AM + (size_t)uidx * 4096 + i * 64 + jb) = w; }
    }
    {
        f32x4 acc[2][8];
#pragma unroll
        for (int a = 0; a < 2; ++a)
#pragma unroll
            for (int yt = 0; yt < 8; ++yt) acc[a][yt] = (f32x4){0.f, 0.f, 0.f, 0.f};
#pragma unroll
        for (int ks = 0; ks < 2; ++ks) { bf16x8 x[2];
#pragma unroll
            for (int a = 0; a < 2; ++a) x[a] = tr_frag<272>(Vn, 2 * wid + a, ks, lane);
#pragma unroll
            for (int yt = 0; yt < 8; ++yt) { const bf16x8 y = tr_frag<136>(Kh, yt, ks, lane);
#pragma unroll
                for (int a = 0; a < 2; ++a) acc[a][yt] = MFMA16(x[a], y, acc[a][yt]); } }
        bf16_t* sp = SUB + ((size_t)bh * NCH + c) * (DK * DV);
#pragma unroll
        for (int a = 0; a < 2; ++a)
#pragma unroll
            for (int yt = 0; yt < 8; ++yt) { u32x2 w; w.x = cvt_pk_bf16(acc[a][yt][0], acc[a][yt][1]); w.y = cvt_pk_bf16(acc[a][yt][2], acc[a][yt][3]); *(u32x2*)(sp + (16 * yt + r) * DV + 32 * wid + 16 * a + 4 * q) = w; }
    }
    __syncthreads();
}
__device__ __forceinline__ void gla_passC(LAS unsigned char* lds, int uidx, const bf16_t* PR, const bf16_t* SUB, const bf16_t* QT, const bf16_t* AM, const float* gn  ,
                                          bf16_t* Y, int tid, int wid, int lane) {
    const int b = uidx >> 7, c = (uidx >> 2) & 31, h = uidx & 3; const int tok0 = b * SEQ + c * 64; const int bh = b * 4 + h;
    LAS bf16_t* Qs = (LAS bf16_t*)lds;
    LAS bf16_t* As = (LAS bf16_t*)(lds + 17408);
    LAS bf16_t* Vn = (LAS bf16_t*)(lds + 26624);
    LAS bf16_t* Sn = (LAS bf16_t*)(lds + 61440);
    LAS float* Of = (LAS float*)(lds + 61440);
    const int r = lane & 15, q = lane >> 4;
    u32x4 ogr[4];
    { const bf16_t* gp0 = PR + (size_t)(tok0 + (tid >> 3)) * PRW + 3072 + h * DV + (tid & 7) * 32;
#pragma unroll
      for (int j = 0; j < 4; ++j) ogr[j] = *(const u32x4*)(gp0 + 8 * j); }
    { const bf16_t* sp = SUB + ((size_t)bh * NCH + c) * (DK * DV);
#pragma unroll
      for (int i = 0; i < 8; ++i) { const int id = tid + 512 * i, k = id >> 5, cc = id & 31; *(LAS u32x4*)(Sn + k * 272 + cc * 8) = *(const u32x4*)(sp + k * DV + cc * 8); } }
#pragma unroll
    for (int i = 0; i < 2; ++i) { const int id = tid + 512 * i, row = id >> 4, cc = id & 15; *(LAS u32x4*)(Qs + row * 136 + cc * 8) = *(const u32x4*)(QT + (size_t)(tok0 + row) * QKD + h * DK + cc * 8); }
    { const int row = tid >> 3, cc = tid & 7; *(LAS u32x4*)(As + row * 72 + cc * 8) = *(const u32x4*)(AM + (size_t)uidx * 4096 + row * 64 + cc * 8); }
    stage_v(Vn, PR, tok0, h, tid);
    __syncthreads();
    f32x4 acc[2][4];
#pragma unroll
    for (int a = 0; a < 2; ++a)
#pragma unroll
        for (int it = 0; it < 4; ++it) acc[a][it] = (f32x4){0.f, 0.f, 0.f, 0.f};
#pragma unroll
    for (int ks = 0; ks < 4; ++ks) { bf16x8 x[2];
#pragma unroll
        for (int a = 0; a < 2; ++a) x[a] = tr_frag<272>(Sn, 2 * wid + a, ks, lane);
#pragma unroll
        for (int it = 0; it < 4; ++it) { const bf16x8 y = *(const LAS bf16x8*)(Qs + (16 * it + r) * 136 + 32 * ks + 8 * q);
#pragma unroll
            for (int a = 0; a < 2; ++a) acc[a][it] = MFMA16(x[a], y, acc[a][it]); } }
#pragma unroll
    for (int ks = 0; ks < 2; ++ks) { bf16x8 x[2];
#pragma unroll
        for (int a = 0; a < 2; ++a) x[a] = tr_frag<272>(Vn, 2 * wid + a, ks, lane);
#pragma unroll
        for (int it = 0; it < 4; ++it) { const bf16x8 y = *(const LAS bf16x8*)(As + (16 * it + r) * 72 + 32 * ks + 8 * q);
#pragma unroll
            for (int a = 0; a < 2; ++a) acc[a][it] = MFMA16(x[a], y, acc[a][it]); } }
    __syncthreads();
#pragma unroll
    for (int a = 0; a < 2; ++a)
#pragma unroll
        for (int it = 0; it < 4; ++it) *(LAS f32x4*)(Of + (16 * it + r) * 260 + 32 * wid + 16 * a + 4 * q) = acc[a][it];
    __syncthreads();
    { const int i = tid >> 3, seg = tid & 7; f32x4 o[8]; float ss = 0.f;
#pragma unroll
      for (int j = 0; j < 8; ++j) { o[j] = *(const LAS f32x4*)(Of + i * 260 + seg * 32 + 4 * j); ss += (o[j].x * o[j].x + o[j].y * o[j].y) + (o[j].z * o[j].z + o[j].w * o[j].w); }
      ss += __shfl_xor(ss, 1); ss += __shfl_xor(ss, 2); ss += __shfl_xor(ss, 4);
      const float rstd = rsqrtf(ss * (1.f / DV) + EPS);
      const bf16_t* gp = PR + (size_t)(tok0 + i) * PRW + 3072 + h * DV + seg * 32; const float* gnp = gn + h * DV + seg * 32; bf16_t* yp = Y + (size_t)(tok0 + i) * DM + 1024 + h * DV + seg * 32;
#pragma unroll
      for (int j = 0; j < 4; ++j) { const u32x4 g = ogr[j]; const f32x4 n0 = *(const f32x4*)(gnp + 8 * j), n1 = *(const f32x4*)(gnp + 8 * j + 4); const f32x4 a0 = o[2 * j], a1 = o[2 * j + 1]; u32x4 w;
          w.x = cvt_pk_bf16(a0.x * rstd * n0.x * silu_f(bf_lo(g.x)), a0.y * rstd * n0.y * silu_f(bf_hi(g.x)));
          w.y = cvt_pk_bf16(a0.z * rstd * n0.z * silu_f(bf_lo(g.y)), a0.w * rstd * n0.w * silu_f(bf_hi(g.y)));
          w.z = cvt_pk_bf16(a1.x * rstd * n1.x * silu_f(bf_lo(g.z)), a1.y * rstd * n1.y * silu_f(bf_hi(g.z)));
          w.w = cvt_pk_bf16(a1.z * rstd * n1.z * silu_f(bf_lo(g.w)), a1.w * rstd * n1.w * silu_f(bf_hi(g.w)));
          *(u32x4*)(yp + 8 * j) = w; } }
    __syncthreads();
}
__device__ __forceinline__ float prs_sum(const float* PRS, int s, int col) { float v = 0.f;
#pragma unroll
    for (int sp = 0; sp < NSP1; ++sp) v += PRS[((size_t)sp * NS + s) * PRSW + col];
    return v; }
__device__ __forceinline__ f32x4 prs_sum4(const float* PRS, int s, int col) { f32x4 v = {0.f, 0.f, 0.f, 0.f};
#pragma unroll
    for (int sp = 0; sp < NSP1; ++sp) v += *(const f32x4*)(PRS + ((size_t)sp * NS + s) * PRSW + col);
    return v; }
template <bool WITH_O> __device__ __forceinline__ void gla_sample(LAS unsigned char* lds, int uidx, const float* PRS, const float* GLRP, const float* w2, const float* gb, const float* gn,
                                           const float* s_in  , float* s_out  , bf16_t* Y, int tid, int wid, int lane) {
    const int s = uidx >> 2, h = uidx & 3; const int row = MP + s;
    LAS float* smA = (LAS float*)lds; LAS float* smK = smA + 128; LAS float* smQ = smK + 128; LAS float* smO = smQ + 128; LAS float* smR = smO + 2048;
    const size_t sb = ((size_t)(s * 4 + h) * DK) * DV + (tid & 63) * 4; f32x4 S[16];
#pragma unroll
    for (int kk = 0; kk < 16; ++kk) S[kk] = __builtin_nontemporal_load((const f32x4*)(s_in + sb + (size_t)(16 * wid + kk) * DV));
    if (tid < DK) { const int col = h * DK + tid; float z = gb[col];
#pragma unroll
        for (int rr = 0; rr < RANK; ++rr) { float g = 0.f;
#pragma unroll
            for (int sp = 0; sp < NSP1; ++sp) g += GLRP[((size_t)sp * MPAD + row) * RANK + rr];
            z += g * w2[rr * QKD + col]; }
        smA[tid] = __expf(logsig_f(z) * (1.f / 16.f)); smK[tid] = prs_sum(PRS, s, 3584 + col); if (WITH_O) smQ[tid] = prs_sum(PRS, s, 3072 + col) * 0.08838834764831845f; }
    const int dv4 = (tid & 63) * 4; const f32x4 v = prs_sum4(PRS, s, 4096 + h * DV + dv4);
    __syncthreads();
    f32x4 o = {0.f, 0.f, 0.f, 0.f};
#pragma unroll
    for (int kk = 0; kk < 16; ++kk) { const int k = 16 * wid + kk; const f32x4 sn = S[kk] * smA[k] + v * smK[k]; if (!WITH_O || !DEFER_STATE) __builtin_nontemporal_store(sn, (f32x4*)(s_out + sb + (size_t)k * DV)); if (WITH_O) o += sn * smQ[k]; }
    if (!WITH_O) { __syncthreads(); return; }
    *(LAS f32x4*)(smO + wid * 256 + dv4) = o;
    __syncthreads();
    float oo = 0.f;
    if (tid < 256) {
#pragma unroll
        for (int w = 0; w < 8; ++w) oo += smO[w * 256 + tid];
        const float ss = wave_sum(oo * oo); if (lane == 0) smR[wid] = ss; }
    __syncthreads();
    if (tid < 256) { const float tot = (smR[0] + smR[1]) + (smR[2] + smR[3]); const float rstd = rsqrtf(tot * (1.f / DV) + EPS);
        const float og = prs_sum(PRS, s, 5120 + h * DV + tid); Y[(size_t)row * DM + 1024 + h * DV + tid] = f2bf(oo * rstd * gn[h * DV + tid] * silu_f(og)); }
    __syncthreads();
}
__device__ __forceinline__ void sample_assemble(const float* base, const float* XSP, int nsp, int s, float* xr, int lane) {
    const f32x4* br = (const f32x4*)base + lane; f32x4* o = (f32x4*)xr + lane;
#pragma unroll
    for (int j = 0; j < 8; ++j) { f32x4 v = br[64 * j];
        for (int sp = 0; sp < nsp; ++sp) v += *((const f32x4*)(XSP + ((size_t)sp * NS + s) * DM) + lane + 64 * j);
        o[64 * j] = v; }
}

template <int PH> struct MixOrder {
    pg8::StaticOrder so; int nfull, ntfull;
    __device__ __forceinline__ void init(int Ncols, int ntf, int G, int c) { so.init(MP, Ncols, G, c); nfull = so.nwg; ntfull = ntf; }
    __device__ __forceinline__ bool next(int i, pg8::Unit& u) const {
        const long L = (long)i * so.G + so.c; int pm = 32, pn = 0, sp = -1, k0 = 0, nt = ntfull; bool ok = true;
        if (L < nfull) { pg8::Unit t; so.next(i, t); pm = t.pm; pn = t.pn; }
        else { const int mi = (int)(L - nfull);
            if (PH == 1) { ok = mi < 57 * NSP1;
                const bool isg = mi < 33 * NSP1; const int m2 = isg ? mi : mi - 33 * NSP1; const int qd = m2 / NSP1; sp = m2 - qd * NSP1; pm = isg ? qd : 32; pn = isg ? 24 : qd; nt = 32 / NSP1; k0 = sp * (32 / NSP1); }
            else if (PH == 2) { ok = mi < 64; pn = mi >> 3; sp = mi & 7; k0 = sp * 4; nt = 4; }
            else if (PH == 3) { ok = mi < 44; pn = mi; nt = 32; }
            else { ok = mi < 88; pn = mi / 11; sp = mi - 11 * pn; k0 = sp * 8; nt = 8; }
        }
        u.pm = pm; u.pn = pn; u.sp = sp; u.k0 = k0; u.nt = nt; return ok;
    }
    __device__ __forceinline__ void a_ready(const pg8::Unit&) const {}
    __device__ __forceinline__ void done(const pg8::Unit&) const {}
};

#define XB_TMO      128
#define XB_XCNT(j)  (256  + 64 * (j))
#define XB_XSUB(j)  (1280 + 64 * (j))
#define XB_XGEN(j)  (2304 + 64 * (j))
#define XB_TOP      3328
#define XB_TOPGEN   3392
#define XCD_BAR_WORDS 3456
#define XB_SPIN_CAP (1u << 18)

__device__ __forceinline__ unsigned xb_ld(unsigned* p)              { return __hip_atomic_load(p, __ATOMIC_RELAXED, __HIP_MEMORY_SCOPE_AGENT); }
__device__ __forceinline__ unsigned xb_add(unsigned* p, unsigned v) { return __hip_atomic_fetch_add(p, v, __ATOMIC_RELAXED, __HIP_MEMORY_SCOPE_AGENT); }
__device__ __forceinline__ unsigned xb_xcc_id() { return (unsigned)__builtin_amdgcn_s_getreg((3 << 11) | 20) & 0xFu; }
#define XB_SPIN(cond, bar) do { unsigned _sp = 0; while (cond) { __builtin_amdgcn_s_sleep(1); \
    if ((++_sp & 255u) == 0u) { if (xb_ld(&(bar)[XB_TMO])) break; if (_sp > XB_SPIN_CAP) { atomicAdd(&(bar)[XB_TMO], 1u); break; } } } } while (0)

struct XcdBarrier {
    unsigned* bar; unsigned x;
    volatile LAS unsigned* st;
};

__device__ __forceinline__ XcdBarrier xcd_barrier_post(unsigned* bar, volatile LAS unsigned* st) {
    XcdBarrier b; b.bar = bar; b.x = xb_xcc_id(); b.st = st;
    if (threadIdx.x == 0) (void)xb_add(&bar[XB_XCNT(b.x)], 1u);
    return b;
}
__device__ __forceinline__ void xcd_barrier_complete(unsigned* bar, unsigned x, unsigned& nloc, unsigned& nx) {
    const unsigned G = gridDim.x * gridDim.y * gridDim.z;
    unsigned sum, cnt, mine, sp = 0u;
    for (;;) {
        sum = 0u; cnt = 0u; mine = 0u;
#pragma unroll
        for (unsigned j = 0; j < 16; ++j) { const unsigned c = xb_ld(&bar[XB_XCNT(j)]); sum += c; cnt += (c > 0u) ? 1u : 0u; mine = (j == x) ? c : mine; }
        if (sum == G) break;
        __builtin_amdgcn_s_sleep(1);
        if ((++sp & 255u) == 0u) { if (xb_ld(&bar[XB_TMO])) break; if (sp > XB_SPIN_CAP) { atomicAdd(&bar[XB_TMO], 1u); break; } }
    }
    nloc = mine > 0u ? mine : 1u; nx = cnt > 0u ? cnt : 1u;
}

__device__ __forceinline__ void xcd_barrier(const XcdBarrier& b) {
    asm volatile("s_waitcnt vmcnt(0)" ::: "memory");
    __syncthreads();
    if (threadIdx.x == 0) {
        unsigned* bar = b.bar;
        __builtin_amdgcn_s_waitcnt(0);
        unsigned nloc = b.st[0], nx = b.st[1];
        if (nloc == 0u) { xcd_barrier_complete(bar, b.x, nloc, nx); b.st[0] = nloc; b.st[1] = nx; }
        const unsigned old = xb_add(&bar[XB_XSUB(b.x)], 1u);
        const unsigned gen = old / nloc;
        if (old + 1u == (gen + 1u) * nloc) {
            __builtin_amdgcn_fence(__ATOMIC_RELEASE, "agent");
            asm volatile("s_waitcnt vmcnt(0)" ::: "memory");
            const unsigned og = xb_add(&bar[XB_TOP], 1u);
            const unsigned tg = og / nx;
            if (og + 1u == (tg + 1u) * nx) xb_add(&bar[XB_TOPGEN], 1u);
            else XB_SPIN(xb_ld(&bar[XB_TOPGEN]) == tg, bar);
            __builtin_amdgcn_fence(__ATOMIC_ACQUIRE, "agent");
            xb_add(&bar[XB_XGEN(b.x)], 1u);
            asm volatile("s_waitcnt vmcnt(0)" ::: "memory");
        } else {
            XB_SPIN(xb_ld(&bar[XB_XGEN(b.x)]) == gen, bar);
            __builtin_amdgcn_fence(__ATOMIC_ACQUIRE, "agent");
            asm volatile("s_waitcnt vmcnt(0)" ::: "memory");
        }
    }
    __syncthreads();
}

struct Args { const float* in[18]; float* out; unsigned char* ws; };
__global__ void __launch_bounds__(NTHR, 2) fwd_kernel(Args a) {
    extern __shared__ __attribute__((aligned(16))) unsigned char lds_raw[];
    LAS unsigned char* lds = (LAS unsigned char*)lds_raw;
    cg::grid_group grid = cg::this_grid();
    if (threadIdx.x < 2) ((volatile LAS unsigned*)(lds + LDS_BARST))[threadIdx.x] = 0u;
    if (blockIdx.x == 0) { unsigned* bw = (unsigned*)(a.ws + WS_BAR); for (int i = threadIdx.x; i < XCD_BAR_WORDS; i += NTHR) __hip_atomic_store(bw + i, 0u, __ATOMIC_RELAXED, __HIP_MEMORY_SCOPE_AGENT); }
    const int G = gridDim.x, bid = blockIdx.x; const int NGW = G * 8, NGT = G * NTHR;
#define PHASE_IDS KP_DECL int tid = threadIdx.x; asm volatile("" : "+v"(tid)); const int lane = tid & 63; const int wid = __builtin_amdgcn_readfirstlane(tid >> 6); const int gw = bid * 8 + wid; const int gt = bid * NTHR + tid; (void)gw; (void)gt; (void)lane;
    typedef const __attribute__((address_space(4))) unsigned char* kargp_t;
#define KP_DECL kargp_t kp_ = (kargp_t)__builtin_amdgcn_kernarg_segment_ptr(); asm volatile("" : "+s"(kp_));
#define KIN(i) (*(const __attribute__((address_space(4))) float* const __attribute__((address_space(4)))*)(kp_ + 8 * (i)))
#define KPTR(i) (*(unsigned char* const __attribute__((address_space(4)))*)(kp_ + 8 * (i)))
#define x_prompt ((const float*)KPTR(0))
#define x_sample ((const float*)KPTR(1))
#define state_conv ((const float*)KPTR(2))
#define state_gla ((const float*)KPTR(3))
#define state_ffn ((const float*)KPTR(4))
#define norm_mix_g ((const float*)KPTR(5))
#define w_in ((const float*)KPTR(6))
#define conv_w ((const float*)KPTR(7))
#define gate_w2 ((const float*)KPTR(8))
#define gate_b ((const float*)KPTR(9))
#define gla_norm_g ((const float*)KPTR(10))
#define w_out ((const float*)KPTR(11))
#define norm_ffn_g ((const float*)KPTR(12))
#define w_up ((const float*)KPTR(13))
#define ffn_conv_w ((const float*)KPTR(14))
#define ffn_conv_b ((const float*)KPTR(15))
#define w_down ((const float*)KPTR(16))
#define final_norm_g ((const float*)KPTR(17))
#define out ((float*)KPTR(18))
#define ws (KPTR(19))
#define WT_IN ((bf16_t*)(ws + WS_WIN))
#define WT_OUT ((bf16_t*)(ws + WS_WOUT))
#define WT_UP ((bf16_t*)(ws + WS_WUP))
#define WT_DN ((bf16_t*)(ws + WS_WDN))
#define XN ((bf16_t*)(ws + WS_XN))
#define XR ((float*)(ws + WS_XR))
#define PR ((bf16_t*)(ws + WS_PR))
#define UC ((float*)(ws + WS_UC))
#define Y ((bf16_t*)(ws + WS_Y))
#define SUB ((bf16_t*)(ws + WS_SU))
#define EB ((float*)(ws + WS_EB))
#define QT ((bf16_t*)(ws + WS_QT))
#define AM ((bf16_t*)(ws + WS_AM))
#define PRS ((float*)(ws + WS_PRS))
#define GLRP ((float*)(ws + WS_GLRP))
#define XSP ((float*)(ws + WS_XSP))
#define H ((bf16_t*)(ws + WS_H))
#define TAIL ((float*)(ws + WS_TAIL))
#define SSB ((float*)(ws + WS_SS))
#define SSP ((float*)(ws + WS_SSP))
#define HEAD ((float*)(ws + WS_HEAD))

    for (int rp_ = 0; rp_ < REP_P0; ++rp_) {
        PHASE_IDS
        LAS float* scr = (LAS float*)(lds + wid * 16384);
#if P0_WG
        { const P0Src ts{w_in, w_out, w_up, w_down, norm_mix_g, norm_ffn_g, WT_IN, WT_OUT, WT_UP, WT_DN}; LAS float* T = (LAS float*)lds;
          int it = bid; P0Desc dc, dn; f32x4 tv[8];
          bool have = p0_decode(it, ts, wid, lane, dc); if (have) p0_load(dc, tv);
          while (have) {
              p0_to_lds(dc, tv, T, wid, lane);
              __syncthreads();
              const bool hn = p0_decode(it + G, ts, wid, lane, dn); if (hn) p0_load(dn, tv);
              p0_out(dc, T, wid, lane);
              __syncthreads();
              have = hn; it += G; dc = dn;
          } }
#else
        constexpr int I_IN = 200 * 32, I_OUT = 64 * 32, I_UP = 352 * 32, I_DN = 64 * 88, I_L = I_IN + I_OUT + I_UP + I_DN;
        for (int it = gw; it < 2 * I_L; it += NGW) {
            const int l = it / I_L; int rr = it - l * I_L;
            if (rr < I_IN) { const int g = rr >> 5, kb = rr & 31; int src, nv; bool perm; win_map(g, src, nv, perm);
                tr_item(w_in + (size_t)l * DM * INC, INC, nv, DM, WT_IN + (size_t)l * INP * DM, g * 32, src, perm, kb, scr, lane, norm_mix_g + (size_t)l * DM); continue; }
            rr -= I_IN;
            if (rr < I_OUT) { const int g = rr >> 5, kb = rr & 31; tr_item(w_out + (size_t)l * DM * DM, DM, DM, DM, WT_OUT + (size_t)l * DM * DM, g * 32, g * 32, false, kb, scr, lane); continue; }
            rr -= I_OUT;
            if (rr < I_UP) { const int g = rr >> 5, kb = rr & 31; const int tile = g >> 3, gi = g & 7; const int src = (gi < 4) ? (128 * tile + 32 * gi) : (DFF + 128 * tile + 32 * (gi - 4));
                tr_item(w_up + (size_t)l * DM * UPN, UPN, UPN, DM, WT_UP + (size_t)l * UPN * DM, g * 32, src, true, kb, scr, lane, norm_ffn_g + (size_t)l * DM); continue; }
            rr -= I_UP;
            { const int g = rr / 88, kb = rr - g * 88; tr_item(w_down + (size_t)l * DFF * DM, DM, DM, DFF, WT_DN + (size_t)l * DM * DFF, g * 32, g * 32, false, kb, scr, lane); }
        }
#endif
        for (int m = gw; m < MPAD; m += NGW) {
            if (m < MREAL) row_bf16_ss(m < MP ? x_prompt + (size_t)m * DM : x_sample + (size_t)(m - MP) * DM, XN + (size_t)m * DM, SSB + m, lane);
            else { u32x4* o = (u32x4*)(XN + (size_t)m * DM) + lane; const u32x4 z = {0u, 0u, 0u, 0u};
#pragma unroll
                for (int j = 0; j < 4; ++j) o[64 * j] = z;
                if (lane == 0) SSB[m] = 0.f; }
        }
        for (int i = gt; i < 3 * MPAD; i += NGT) SSB[MPAD + i] = 0.f;
    }
    grid.sync();
    unsigned* barw_; { KP_DECL barw_ = (unsigned*)(ws + WS_BAR); }
    XcdBarrier xbar; xbar.bar = barw_; xbar.x = xb_xcc_id(); xbar.st = (volatile LAS unsigned*)(lds + LDS_BARST);
#define GRID_BAR() xcd_barrier(xbar)
    volatile LAS unsigned* vcw = (volatile LAS unsigned*)(lds + LDS_BARST + 16);
    if (threadIdx.x == 0) vcw[0] = xb_add(&barw_[XB_XCNT(xbar.x)], 1u);
    GRID_BAR();
    if (threadIdx.x == 0) { bool even = (G == 256);
        for (unsigned j = 0; j < 8; ++j) even = even && (xb_ld(&barw_[XB_XCNT(j)]) == 32u);
        vcw[1] = even ? vcw[0] * 8u + xbar.x : (unsigned)bid; }
    __syncthreads();
    const int vcu = __builtin_amdgcn_readfirstlane((int)vcw[1]);

#pragma unroll 1
    for (int l = 0; l < 2; ++l) {
        for (int rp_ = 0; rp_ < REP_G1; ++rp_) { KP_DECL pg8::Gemm g{XN, WT_IN + (size_t)l * INP * DM, MPAD, INP, DM}; MixOrder<1> S; S.init(6144, 32, G, vcu);
          EpiIn E{PR, UC, GLRP, PRS, SSB + (size_t)(2 * l) * MPAD, out + O_CP + (size_t)l * NBATCH * 2 * CONVD};
          pg8::gemm_phase<EpiIn, MixOrder<1>, true, true>(lds, g, S, E); }
        GRID_BAR();
        for (int rp_ = 0; rp_ < REP_M1; ++rp_) {
            PHASE_IDS
            const float* w2 = gate_w2 + (size_t)l * RANK * QKD; const float* gb = gate_b + (size_t)l * QKD; const float* gn = gla_norm_g + (size_t)l * 1024;
            for (int ra_ = 0; ra_ < REP_M1A; ++ra_) for (int u = bid; u < 512; u += G) gla_passA(lds, u, PR, GLRP, w2, gb, SUB, EB, QT, AM, tid, wid, lane);
            for (int rs_ = 0; rs_ < REP_M1S; ++rs_) for (int u = bid; u < 512; u += G) gla_sample<true>(lds, u, PRS, GLRP, w2, gb, gn, state_gla + (size_t)l * NS * NH * DK * DV, out + O_GS + (size_t)l * NS * NH * DK * DV, Y, tid, wid, lane);
            const float* cw = conv_w + (size_t)l * 3 * CONVD;
            for (int rc_ = 0; rc_ < REP_M1C; ++rc_) for (int item = gt; item < (MP / 16) * 256; item += NGT) {
                const int c4 = (item & 255) * 4, row0 = (item >> 8) * 16; const bool cont = (row0 & (SEQ - 1)) != 0; const bf16_t* up = (const bf16_t*)UC + (size_t)row0 * CONVD + c4; const f32x4 z = {0.f, 0.f, 0.f, 0.f};
                f32x4 u[18]; u32x2 bg[16];
                u32x2 ub[18]; ub[0] = cont ? *(const u32x2*)(up - 2 * CONVD) : (u32x2){0u, 0u}; ub[1] = cont ? *(const u32x2*)(up - CONVD) : (u32x2){0u, 0u};
#pragma unroll
                for (int i = 0; i < 16; ++i) { ub[2 + i] = *(const u32x2*)(up + (size_t)i * CONVD); bg[i] = *(const u32x2*)(PR + (size_t)(row0 + i) * PRW + c4); }
                const f32x4 w0 = *(const f32x4*)(cw + c4), w1 = *(const f32x4*)(cw + CONVD + c4), w2v = *(const f32x4*)(cw + 2 * CONVD + c4);
#pragma unroll
                for (int i = 0; i < 18; ++i) u[i] = (f32x4){bf_lo(ub[i].x), bf_hi(ub[i].x), bf_lo(ub[i].y), bf_hi(ub[i].y)};
#pragma unroll
                for (int i = 0; i < 16; ++i) { const f32x4 bgf = {bf_lo(bg[i].x), bf_hi(bg[i].x), bf_lo(bg[i].y), bf_hi(bg[i].y)};
                    const f32x4 cu = (u[i] * w0 + u[i + 1] * w1 + u[i + 2] * w2v) * bgf;
                    u32x2 w; w.x = cvt_pk_bf16(cu.x, cu.y); w.y = cvt_pk_bf16(cu.z, cu.w);
                    *(u32x2*)(Y + (size_t)(row0 + i) * DM + c4) = w; }
            }
            for (int idx = gt; idx < NS * 256; idx += NGT) { const int s = idx >> 8, c4 = (idx & 255) * 4; const int row = MP + s;
                const f32x4 u0 = prs_sum4(PRS, s, 1024 + c4) * prs_sum4(PRS, s, 2048 + c4), bgf = prs_sum4(PRS, s, c4);
                const float* sp = state_conv + ((size_t)l * NS + s) * 2 * CONVD + c4; const f32x4 u2 = *(const f32x4*)sp, u1 = *(const f32x4*)(sp + CONVD);
                float* op = out + O_CS + ((size_t)l * NS + s) * 2 * CONVD + c4; *(f32x4*)op = u1; *(f32x4*)(op + CONVD) = u0;
                const f32x4 w0 = *(const f32x4*)(cw + c4), w1 = *(const f32x4*)(cw + CONVD + c4), w2v = *(const f32x4*)(cw + 2 * CONVD + c4);
                const f32x4 cu = (u2 * w0 + u1 * w1 + u0 * w2v) * bgf;
                u32x2 w; w.x = cvt_pk_bf16(cu.x, cu.y); w.y = cvt_pk_bf16(cu.z, cu.w);
                *(u32x2*)(Y + (size_t)row * DM + c4) = w; }
        }
        GRID_BAR();
        { PHASE_IDS
        for (int e = gt; e < 16 * DK * 64; e += NGT) { const int bh = e >> 13, rem = e & 8191, k = rem >> 6, dq = rem & 63;
            bf16_t* sp = SUB + (size_t)bh * NCH * (DK * DV) + k * DV + 4 * dq; const float* ep = EB + (size_t)bh * NCH * DK + k; f32x4 S = {0.f, 0.f, 0.f, 0.f};
#pragma unroll 1
            for (int c0 = 0; c0 < NCH; c0 += 16) { u32x2 uu[16]; float ee[16];
#pragma unroll
                for (int i = 0; i < 16; ++i) { uu[i] = *(const u32x2*)(sp + (size_t)(c0 + i) * (DK * DV)); ee[i] = ep[(c0 + i) * DK]; }
#pragma unroll
                for (int i = 0; i < 16; ++i) { u32x2 w; w.x = cvt_pk_bf16(S.x, S.y); w.y = cvt_pk_bf16(S.z, S.w); *(u32x2*)(sp + (size_t)(c0 + i) * (DK * DV)) = w;
                    S = S * ee[i] + (f32x4){bf_lo(uu[i].x), bf_hi(uu[i].x), bf_lo(uu[i].y), bf_hi(uu[i].y)}; } }
            *(f32x4*)(out + O_GP + ((size_t)l * 16 + bh) * (DK * DV) + k * DV + 4 * dq) = S; } }
        GRID_BAR();
        for (int rp_ = 0; rp_ < REP_M3; ++rp_) { PHASE_IDS const float* gn = gla_norm_g + (size_t)l * 1024; for (int u = bid; u < 512; u += G) gla_passC(lds, u, PR, SUB, QT, AM, gn, Y, tid, wid, lane); }
        GRID_BAR();
        { KP_DECL pg8::Gemm g{Y, WT_OUT + (size_t)l * DM * DM, MPAD, DM, DM}; MixOrder<2> S; S.init(DM, 32, G, vcu);
          EpiRes E{nullptr, nullptr, XSP, XN, SSP};
          pg8::gemm_phase<EpiRes, MixOrder<2>, true, true>(lds, g, S, E); }
        GRID_BAR();
        for (int rp_ = 0; rp_ < REP_NRM; ++rp_) { PHASE_IDS
              for (int r = gt; r < MP; r += NGT) { const f32x4* sp = (const f32x4*)(SSP + (size_t)r * 32); f32x4 t = sp[0];
#pragma unroll
                  for (int j = 1; j < 8; ++j) t += sp[j];
                  SSB[(size_t)(2 * l + 1) * MPAD + r] = (t.x + t.y) + (t.z + t.w); }
              for (int m = MP + gw; m < MREAL; m += NGW) {
                  if (rp_ == 0) sample_assemble(l == 0 ? x_sample + (size_t)(m - MP) * DM : XR + (size_t)m * DM, XSP, 8, m - MP, XR + (size_t)m * DM, lane);
                  row_bf16_ss(XR + (size_t)m * DM, XN + (size_t)m * DM, SSB + (size_t)(2 * l + 1) * MPAD + m, lane); } }
        GRID_BAR();
        for (int rp_ = 0; rp_ < REP_UP; ++rp_) { KP_DECL pg8::Gemm g{XN, WT_UP + (size_t)l * UPN * DM, MPAD, UPN, DM}; MixOrder<3> S; S.init(UPN, 32, G, vcu);
          EpiUp E{H, ffn_conv_w + (size_t)l * 3 * DFF, ffn_conv_b + (size_t)l * DFF, TAIL, HEAD, state_ffn + (size_t)l * NS * 2 * DFF, out + O_FP + (size_t)l * NBATCH * 2 * DFF, out + O_FS + (size_t)l * NS * 2 * DFF, (LAS float*)(lds + LDS_HALO), SSB + (size_t)(2 * l + 1) * MPAD};
          pg8::gemm_phase<EpiUp, MixOrder<3>, true, true>(lds, g, S, E); }
        {
            PHASE_IDS const int first = (G == 256) ? 172 : 0, nw = G - first;
            const float* w2 = gate_w2 + (size_t)l * RANK * QKD; const float* gb = gate_b + (size_t)l * QKD;
            if (DEFER_STATE && bid >= first) for (int u = bid - first; u < 512; u += nw) gla_sample<false>(lds, u, PRS, GLRP, w2, gb, nullptr, state_gla + (size_t)l * NS * NH * DK * DV, out + O_GS + (size_t)l * NS * NH * DK * DV, nullptr, tid, wid, lane);
        }
        GRID_BAR();
        { PHASE_IDS MixOrder<4> S0; S0.init(DM, 88, G, vcu); pg8::Unit u0;
          for (int ui = 0; S0.next(ui, u0); ++ui) if (u0.sp < 0 && (u0.pm & 7) != 0) { const int pm = u0.pm; const float* cw = ffn_conv_w + (size_t)l * 3 * DFF; const float* cb = ffn_conv_b + (size_t)l * DFF;
            for (int idx = tid; idx < 2 * (DFF / 4); idx += NTHR) { const int j = idx / (DFF / 4), c4 = (idx - j * (DFF / 4)) * 4;
              const f32x4 t0 = *(const f32x4*)(TAIL + ((size_t)(pm - 1) * 2 + 0) * DFF + c4), t1 = *(const f32x4*)(TAIL + ((size_t)(pm - 1) * 2 + 1) * DFF + c4);
              const f32x4 hu0 = *(const f32x4*)(HEAD + ((size_t)pm * 2 + 0) * 2 * DFF + c4), hu1 = *(const f32x4*)(HEAD + ((size_t)pm * 2 + 1) * 2 * DFF + c4), hv = *(const f32x4*)(HEAD + ((size_t)pm * 2 + j) * 2 * DFF + DFF + c4);
              const f32x4 w0 = *(const f32x4*)(cw + c4), w1 = *(const f32x4*)(cw + DFF + c4), w2v = *(const f32x4*)(cw + 2 * DFF + c4), bv = *(const f32x4*)(cb + c4);
              const f32x4 cu = j == 0 ? (t0 * w0 + t1 * w1 + hu0 * w2v + bv) : (t1 * w0 + hu0 * w1 + hu1 * w2v + bv);
              u32x2 w; w.x = cvt_pk_bf16(silu_f(cu.x) * hv.x, silu_f(cu.y) * hv.y); w.y = cvt_pk_bf16(silu_f(cu.z) * hv.z, silu_f(cu.w) * hv.w);
              *(u32x2*)(H + (size_t)(pm * 256 + j) * DFF + c4) = w; }
            asm volatile("s_waitcnt vmcnt(0)" ::: "memory"); }
          __syncthreads(); }
        { KP_DECL pg8::Gemm g{H, WT_DN + (size_t)l * DM * DFF, MPAD, DM, DFF}; MixOrder<4> S; S.init(DM, 88, G, vcu);
          EpiRes E{nullptr, nullptr, XSP, XN, l == 0 ? SSP : nullptr};
          pg8::gemm_phase<EpiRes, MixOrder<4>, true, true>(lds, g, S, E); }
        GRID_BAR();
        if (l == 0) { PHASE_IDS
              for (int r = gt; r < MP; r += NGT) { const f32x4* sp = (const f32x4*)(SSP + (size_t)r * 32); f32x4 t = sp[0];
#pragma unroll
                  for (int j = 1; j < 8; ++j) t += sp[j];
                  SSB[(size_t)2 * MPAD + r] = (t.x + t.y) + (t.z + t.w); }
              for (int m = MP + gw; m < MREAL; m += NGW) { sample_assemble(XR + (size_t)m * DM, XSP, 11, m - MP, XR + (size_t)m * DM, lane);
                  row_bf16_ss(XR + (size_t)m * DM, XN + (size_t)m * DM, SSB + (size_t)2 * MPAD + m, lane); }
            GRID_BAR(); }
    }
    PHASE_IDS
    for (int m = gw; m < MREAL; m += NGW) {
        if (m >= MP) { sample_assemble(XR + (size_t)m * DM, XSP, 11, m - MP, XR + (size_t)m * DM, lane); rms_row_f32(XR + (size_t)m * DM, final_norm_g, out + O_YS + (size_t)(m - MP) * DM, lane); }
        else { const u32x2* xr = (const u32x2*)(XN + (size_t)m * DM) + lane; f32x4 v[8]; float sq = 0.f;
#pragma unroll
            for (int j = 0; j < 8; ++j) { const u32x2 w = xr[64 * j]; v[j] = (f32x4){bf_lo(w.x), bf_hi(w.x), bf_lo(w.y), bf_hi(w.y)}; sq += (v[j].x * v[j].x + v[j].y * v[j].y) + (v[j].z * v[j].z + v[j].w * v[j].w); }
            const float rstd = rsqrtf(wave_sum(sq) * (1.f / DM) + EPS); const f32x4* gr = (const f32x4*)final_norm_g + lane; f32x4* o = (f32x4*)(out + O_YP + (size_t)m * DM) + lane;
#pragma unroll
            for (int j = 0; j < 8; ++j) o[64 * j] = v[j] * rstd * gr[64 * j]; } }
}

#undef x_prompt
#undef x_sample
#undef state_conv
#undef state_gla
#undef state_ffn
#undef norm_mix_g
#undef w_in
#undef conv_w
#undef gate_w2
#undef gate_b
#undef gla_norm_g
#undef w_out
#undef norm_ffn_g
#undef w_up
#undef ffn_conv_w
#undef ffn_conv_b
#undef w_down
#undef final_norm_g
#undef out
#undef ws
#undef WT_IN
#undef WT_OUT
#undef WT_UP
#undef WT_DN
#undef XN
#undef XR
#undef PR
#undef UC
#undef Y
#undef SUB
#undef EB
#undef QT
#undef AM
#undef PRS
#undef GLRP
#undef XSP
#undef H
#undef TAIL
#undef SSB
#undef SSP
#undef HEAD
extern "C" void kernel_launch(void* const* d_in, const int* in_sizes, int n_in, void* d_out, int out_size, void* d_ws, size_t ws_size, hipStream_t stream) {
    static int grid = 0;
    if (grid == 0) {
        if (n_in != 18 || (size_t)out_size != O_TOTAL || ws_size < WS_TOTAL) { fprintf(stderr, "kernel_launch: unexpected shapes: n_in %d out %d ws %zu (need %zu)\n", n_in, out_size, ws_size, (size_t)WS_TOTAL); grid = -1; return; }
        int dev = 0, cus = 0, per_cu = 0;
        hipGetDevice(&dev); hipDeviceGetAttribute(&cus, hipDeviceAttributeMultiprocessorCount, dev);
        if (hipFuncSetAttribute((const void*)fwd_kernel, hipFuncAttributeMaxDynamicSharedMemorySize, LDS_BYTES) != hipSuccess) { fprintf(stderr, "kernel_launch: hipFuncSetAttribute failed\n"); grid = -1; return; }
        if (hipOccupancyMaxActiveBlocksPerMultiprocessor(&per_cu, (const void*)fwd_kernel, NTHR, LDS_BYTES) != hipSuccess || per_cu < 1) { fprintf(stderr, "kernel_launch: occupancy query says %d\n", per_cu); per_cu = 1; }
        (void)hipGetLastError();
        grid = cus;
    }
    if (grid < 0) return;
    Args a{};
    for (int i = 0; i < 18; ++i) a.in[i] = (const float*)d_in[i];
    a.out = (float*)d_out; a.ws = (unsigned char*)d_ws;
    void* args[] = {&a};
    hipError_t e = hipLaunchCooperativeKernel((const void*)fwd_kernel, dim3(grid), dim3(NTHR), args, LDS_BYTES, stream);
    if (e != hipSuccess) fprintf(stderr, "kernel_launch: cooperative launch failed: %s (grid %d)\n", hipGetErrorString(e), grid);
}
```

```cpp
#define TR_GATHER 1
#include <hip/hip_runtime.h>
#include <hip/hip_cooperative_groups.h>
#include <cstdio>
#include <cstdint>
namespace cg = cooperative_groups;
namespace pg8 {
#define PG8_LAS __attribute__((address_space(3)))
typedef unsigned short bf16_t;
typedef short bf16x8 __attribute__((ext_vector_type(8)));
typedef float f32x4 __attribute__((ext_vector_type(4)));
typedef unsigned u32x4 __attribute__((ext_vector_type(4)));
constexpr int BM = 256, BK = 64, HALF = 128, HTB = HALF * BK * 2  , STAGE_BYTES = 8 * HTB, NXCD = 8, WGM = 8;

__host__ __device__ __forceinline__ int lds_byte(int r, int c) { const int st = (r >> 4) * 2 + (c >> 5), rr = r & 15, cc = c & 31, ob = rr * 64 + cc * 2; return st * 1024 + (ob ^ (((ob >> 9) & 1) << 5)); }
__host__ __device__ __forceinline__ void stage_rc(int b, int& R, int& C) { const int st = b / 1024, sb = b % 1024, swz = sb ^ (((sb >> 9) & 1) << 5); R = (st >> 1) * 16 + swz / 64; C = (st & 1) * 32 + (swz % 64) / 2; }
__host__ __device__ __forceinline__ int perm32(int rho) { const int n = rho >> 4, i = rho & 15; return 8 * (i >> 2) + 4 * n + (i & 3); }

struct Unit { int pm, pn, k0, nt, sp; };
struct Gemm { const bf16_t* A; const bf16_t* Bt; int M, N, K; };

struct StaticOrder {
    int nM, nN, nwg, G, c;
    __host__ __device__ void init(int M, int N, int G_, int c_) { nM = M / BM; nN = N / BM; nwg = nM * nN; G = G_; c = c_; }
    __host__ __device__ bool next(int i, Unit& u) const {
        const long L = (long)i * G + c; if (L >= nwg) return false;
        int wgid = (int)L; { const int q = nwg / NXCD, r = nwg % NXCD, xcd = wgid % NXCD, off = wgid / NXCD; wgid = (xcd < r ? xcd * (q + 1) : r * (q + 1) + (xcd - r) * q) + off; }
        const int nig = WGM * nN, gid = wgid / nig, fm = gid * WGM, gsz = (nM - fm) < WGM ? (nM - fm) : WGM;
        u.pm = fm + ((wgid % nig) % gsz); u.pn = (wgid % nig) / gsz; u.k0 = 0; u.sp = -1; return true;
    }
    __device__ __forceinline__ void a_ready(const Unit&) const {}
    __device__ __forceinline__ void done(const Unit&) const {}
};
__device__ __forceinline__ unsigned cvt_pk_bf16(float lo, float hi) { unsigned r; asm volatile("v_cvt_pk_bf16_f32 %0, %1, %2" : "=v"(r) : "v"(lo), "v"(hi)); return r; }
typedef float f32x2 __attribute__((ext_vector_type(2)));
template <class Epi, class Sched, bool ALIGN_EPI = false, bool SP2 = false>
__device__ __forceinline__ void gemm_phase(PG8_LAS unsigned char* lds, const Gemm g, const Sched& S, const Epi& E) {
    int tid = threadIdx.x; asm volatile("" : "+v"(tid)); const int wid = __builtin_amdgcn_readfirstlane(tid >> 6), lane = tid & 63, wr = wid >> 2, wc = wid & 3, fr = lane & 15, fq = lane >> 4;
    const int K = g.K;
    unsigned voffA[2], voffB[2];
#pragma unroll
    for (int i = 0; i < 2; ++i) { int R, C; stage_rc(tid * 16 + i * 8192, R, C); const int Rb = Epi::PERM ? ((R & ~31) + perm32(R & 31)) : R;
        voffA[i] = (unsigned)(R * K + C) * 2u; voffB[i] = (unsigned)(Rb * K + C) * 2u; }
    const size_t kstep = (size_t)(BK * 2);
    const size_t hstep = (size_t)HALF * K * 2;
    const size_t tstep = 2 * hstep;
    const unsigned ldsw = (unsigned)wid * 1024u;
    const int aoff = lds_byte(wr * 64 + fr, fq * 8), boff = lds_byte(wc * 32 + fr, fq * 8);
#define PG8_SA(b, h) (((b) * 2 + (h)) * HTB)
#define PG8_SB(b, h) ((4 + (b) * 2 + (h)) * HTB)
#define PG8_STAGE(bufoff, gbase, voff) do { _Pragma("unroll") for (int _i = 0; _i < 2; ++_i) \
        __builtin_amdgcn_global_load_lds((const unsigned*)((const char*)(gbase) + (voff)[_i]), (PG8_LAS unsigned*)(lds + (bufoff) + ldsw + _i * 8192), 16, 0, 0); } while (0)
#define PG8_LDA(dst, b, h) do { _Pragma("unroll") for (int m = 0; m < 4; ++m) _Pragma("unroll") for (int k = 0; k < 2; ++k) dst[m][k] = *(const PG8_LAS bf16x8*)(lds + PG8_SA(b, h) + aoff + m * 2048 + k * 1024); } while (0)
#define PG8_LDB(dst, b, h) do { _Pragma("unroll") for (int n = 0; n < 2; ++n) _Pragma("unroll") for (int k = 0; k < 2; ++k) dst[n][k] = *(const PG8_LAS bf16x8*)(lds + PG8_SB(b, h) + boff + n * 2048 + k * 1024); } while (0)
#define PG8_MMA(ai, bj, At, Bt) do { __builtin_amdgcn_s_setprio(1); _Pragma("unroll") for (int m = 0; m < 4; ++m) _Pragma("unroll") for (int n = 0; n < 2; ++n) _Pragma("unroll") for (int k = 0; k < 2; ++k) \
        acc[ai][bj][m][n] = __builtin_amdgcn_mfma_f32_16x16x32_bf16(Bt[n][k], At[m][k], acc[ai][bj][m][n], 0, 0, 0); __builtin_amdgcn_s_setprio(0); } while (0)
#define PG8_WAIT_V(n) asm volatile("s_waitcnt vmcnt(" #n ")" ::: "memory")
#define PG8_WAIT_L(n) asm volatile("s_waitcnt lgkmcnt(" #n ")" ::: "memory")
#define PG8_BAR __builtin_amdgcn_s_barrier()
#define PG8_SCHED __builtin_amdgcn_sched_barrier(0)
    Unit cur, nxt; int ui = 0;
    if (!S.next(0, cur)) return;
    f32x4 acc[2][2][4][2];
#pragma unroll
    for (int a = 0; a < 2; ++a)
#pragma unroll
        for (int b = 0; b < 2; ++b)
#pragma unroll
            for (int m = 0; m < 4; ++m)
#pragma unroll
                for (int n = 0; n < 2; ++n) acc[a][b][m][n] = (f32x4){0.f, 0.f, 0.f, 0.f};
    bf16x8 At[4][2], B0[2][2], B1[2][2];
    const char* cA = (const char*)g.A + (size_t)cur.pm * tstep + (size_t)cur.k0 * kstep; const char* cB = (const char*)g.Bt + (size_t)cur.pn * tstep + (size_t)cur.k0 * kstep;
    S.a_ready(cur);
    if constexpr (SP2) {
        PG8_STAGE(PG8_SB(0, 0), cB, voffB); PG8_STAGE(PG8_SB(0, 1), cB + hstep, voffB); PG8_STAGE(PG8_SA(0, 0), cA, voffA); PG8_STAGE(PG8_SA(0, 1), cA + hstep, voffA);
        if (wr == 1) PG8_BAR;
        PG8_WAIT_V(2); PG8_BAR;
        PG8_STAGE(PG8_SB(1, 0), cB + kstep, voffB); PG8_STAGE(PG8_SA(1, 0), cA + kstep, voffA); PG8_STAGE(PG8_SB(1, 1), cB + hstep + kstep, voffB);
        PG8_WAIT_V(6); PG8_BAR;
    } else {
        PG8_STAGE(PG8_SB(0, 0), cB, voffB); PG8_STAGE(PG8_SA(0, 0), cA, voffA); PG8_STAGE(PG8_SB(0, 1), cB + hstep, voffB); PG8_STAGE(PG8_SA(0, 1), cA + hstep, voffA);
        if (wr == 1) PG8_BAR;
        PG8_WAIT_V(4); PG8_BAR;
        PG8_STAGE(PG8_SB(1, 0), cB + kstep, voffB); PG8_STAGE(PG8_SA(1, 0), cA + kstep, voffA); PG8_STAGE(PG8_SB(1, 1), cB + hstep + kstep, voffB);
        PG8_WAIT_V(6); PG8_BAR;
    }
    for (;;) {
        const bool has_next = S.next(ui + 1, nxt);
        const char* nA = has_next ? (const char*)g.A + (size_t)nxt.pm * tstep + (size_t)nxt.k0 * kstep : cA; const char* nB = has_next ? (const char*)g.Bt + (size_t)nxt.pn * tstep + (size_t)nxt.k0 * kstep : cB;
        const int nt = cur.nt;
        for (int t = 0; t < nt; t += 2) {
            const bool last = (t == nt - 2);
            const char* a1 = cA + (size_t)(t + 1) * kstep;
            const char* a2 = last ? nA : cA + (size_t)(t + 2) * kstep; const char* b2 = last ? nB : cB + (size_t)(t + 2) * kstep;
            const char* a3 = a2 + kstep; const char* b3 = b2 + kstep;
            if (last && has_next) S.a_ready(nxt);
            if constexpr (SP2) {
            PG8_LDB(B0, 0, 0); PG8_LDB(B1, 0, 1); PG8_SCHED; PG8_LDA(At, 0, 0); PG8_STAGE(PG8_SA(1, 1), a1 + hstep, voffA);
            PG8_WAIT_V(8); PG8_WAIT_L(0); PG8_BAR; PG8_MMA(0, 0, At, B0); PG8_MMA(0, 1, At, B1); PG8_BAR; PG8_SCHED;
            PG8_LDA(At, 0, 1); PG8_STAGE(PG8_SB(0, 0), b2, voffB); PG8_STAGE(PG8_SB(0, 1), b2 + hstep, voffB); PG8_STAGE(PG8_SA(0, 0), a2, voffA);
            PG8_WAIT_V(8); PG8_WAIT_L(0); PG8_BAR; PG8_MMA(1, 0, At, B0); PG8_MMA(1, 1, At, B1); PG8_BAR; PG8_SCHED;
            PG8_LDB(B0, 1, 0); PG8_LDB(B1, 1, 1); PG8_SCHED; PG8_LDA(At, 1, 0); PG8_STAGE(PG8_SA(0, 1), a2 + hstep, voffA);
            PG8_WAIT_V(8); PG8_WAIT_L(0); PG8_BAR; PG8_MMA(0, 0, At, B0); PG8_MMA(0, 1, At, B1); PG8_BAR; PG8_SCHED;
            PG8_LDA(At, 1, 1); PG8_STAGE(PG8_SB(1, 0), b3, voffB); PG8_STAGE(PG8_SB(1, 1), b3 + hstep, voffB); PG8_STAGE(PG8_SA(1, 0), a3, voffA);
            PG8_WAIT_V(8); PG8_WAIT_L(0); PG8_BAR; PG8_MMA(1, 0, At, B0); PG8_MMA(1, 1, At, B1); PG8_BAR; PG8_SCHED;
            } else {
            PG8_LDB(B0, 0, 0); PG8_SCHED; PG8_LDA(At, 0, 0); PG8_STAGE(PG8_SA(1, 1), a1 + hstep, voffA);
            PG8_WAIT_L(8); PG8_BAR; PG8_WAIT_L(0); PG8_MMA(0, 0, At, B0); PG8_BAR; PG8_SCHED;
            PG8_LDB(B1, 0, 1); PG8_STAGE(PG8_SB(0, 0), b2, voffB);
            PG8_BAR; PG8_WAIT_L(0); PG8_MMA(0, 1, At, B1); PG8_BAR;
            PG8_LDA(At, 0, 1); PG8_STAGE(PG8_SA(0, 0), a2, voffA);
            PG8_BAR; PG8_WAIT_L(0); PG8_MMA(1, 0, At, B0); PG8_BAR; PG8_SCHED;
            PG8_STAGE(PG8_SB(0, 1), b2 + hstep, voffB);
            PG8_WAIT_V(6); PG8_BAR; PG8_MMA(1, 1, At, B1); PG8_BAR;
            PG8_LDB(B0, 1, 0); PG8_SCHED; PG8_LDA(At, 1, 0); PG8_STAGE(PG8_SA(0, 1), a2 + hstep, voffA);
            PG8_WAIT_L(8); PG8_BAR; PG8_WAIT_L(0); PG8_MMA(0, 0, At, B0); PG8_BAR; PG8_SCHED;
            PG8_LDB(B1, 1, 1); PG8_STAGE(PG8_SB(1, 0), b3, voffB);
            PG8_BAR; PG8_WAIT_L(0); PG8_MMA(0, 1, At, B1); PG8_BAR;
            PG8_LDA(At, 1, 1); PG8_STAGE(PG8_SA(1, 0), a3, voffA);
            PG8_BAR; PG8_WAIT_L(0); PG8_MMA(1, 0, At, B0); PG8_BAR; PG8_SCHED;
            PG8_STAGE(PG8_SB(1, 1), b3 + hstep, voffB);
            PG8_WAIT_V(6); PG8_BAR; PG8_MMA(1, 1, At, B1); PG8_BAR;
            }
        }
        if constexpr (ALIGN_EPI) { if (wr == 0) PG8_BAR; }
        if constexpr (!Epi::AFTER_DRAIN) { E(acc, cur, wr, wc, fr, fq); S.done(cur); }
        if (!has_next) break;
#pragma unroll
        for (int a = 0; a < 2; ++a)
#pragma unroll
            for (int b = 0; b < 2; ++b)
#pragma unroll
                for (int m = 0; m < 4; ++m)
#pragma unroll
                    for (int n = 0; n < 2; ++n) acc[a][b][m][n] = (f32x4){0.f, 0.f, 0.f, 0.f};
        cur = nxt; cA = nA; cB = nB; ++ui;
        if constexpr (ALIGN_EPI) { if (wr == 1) PG8_BAR; }
    }
    PG8_WAIT_V(0);
    if constexpr (!ALIGN_EPI) { if (wr == 0) PG8_BAR; }
    PG8_BAR;
    if constexpr (Epi::AFTER_DRAIN) { E.fused(acc, cur, wr, wc, fr, fq, lds, wid, lane); S.done(cur); }
#undef PG8_SA
#undef PG8_SB
#undef PG8_STAGE
#undef PG8_LDA
#undef PG8_LDB
#undef PG8_MMA
#undef PG8_WAIT_V
#undef PG8_WAIT_L
#undef PG8_BAR
#undef PG8_SCHED
}
}

#ifndef REP_P0
#define REP_P0 1
#endif
#ifndef REP_G1
#define REP_G1 1
#endif
#ifndef REP_M1
#define REP_M1 1
#endif
#ifndef REP_M3
#define REP_M3 1
#endif
#ifndef REP_UP
#define REP_UP 1
#endif
#ifndef REP_ACT
#define REP_ACT 1
#endif
#ifndef REP_NRM
#define REP_NRM 1
#endif
#ifndef DEFER_STATE
#define DEFER_STATE 0
#endif
#ifndef REP_M1A
#define REP_M1A 1
#endif
#ifndef REP_M1S
#define REP_M1S 1
#endif
#ifndef REP_M1C
#define REP_M1C 1
#endif
#ifndef NT_EPI
#define NT_EPI 0
#endif
#if NT_EPI
#define EPI_ST(p, v) __builtin_nontemporal_store((v), (p))
#else
#define EPI_ST(p, v) (*(p) = (v))
#endif
#ifndef RUN_FIX
#define RUN_FIX 0
#endif
#ifndef P0_WG
#define P0_WG 1
#endif
using pg8::bf16_t; using pg8::bf16x8; using pg8::f32x4; using pg8::u32x4; using pg8::cvt_pk_bf16;
typedef unsigned u32x2 __attribute__((ext_vector_type(2)));
#define LAS __attribute__((address_space(3)))
constexpr int DM = 2048, SEQ = 2048, NBATCH = 4, MP = 8192, NS = 128, MREAL = 8320, MPAD = 8448;
constexpr int CONVD = 1024, NH = 4, DK = 128, DV = 256, QKD = 512, RANK = 16, DFF = 5632;
constexpr int INC = 6160, INP = 6400, UPN = 11264, PRW = 4096;
constexpr int NCH = 32, NTHR = 512;
constexpr float EPS = 1e-6f;
constexpr size_t O_YP = 0, O_YS = 16777216, O_CP = 17039360, O_GP = 17055744, O_FP = 18104320, O_CS = 18194432, O_GS = 18718720, O_FS = 52273152, O_TOTAL = 55156736;
constexpr size_t SZ_WIN = (size_t)INP * DM * 2, SZ_WOUT = (size_t)DM * DM * 2, SZ_WUP = (size_t)UPN * DM * 2, SZ_WDN = (size_t)DM * DFF * 2;
constexpr size_t WS_WIN = 0, WS_WOUT = WS_WIN + 2 * SZ_WIN, WS_WUP = WS_WOUT + 2 * SZ_WOUT, WS_WDN = WS_WUP + 2 * SZ_WUP;
constexpr size_t WS_XN = WS_WDN + 2 * SZ_WDN, WS_XR = WS_XN + (size_t)MPAD * DM * 2, WS_R = WS_XR + (size_t)MPAD * DM * 4;
constexpr size_t WS_PR = WS_R, WS_UC = WS_PR + (size_t)MPAD * PRW * 2, WS_GLR = WS_UC + (size_t)MPAD * CONVD * 4, WS_Y = WS_GLR + (size_t)MPAD * RANK * 4;
constexpr size_t WS_SU = WS_Y + (size_t)MPAD * DM * 2, WS_EB = WS_SU + (size_t)16 * NCH * DK * DV * 4, WS_QT = WS_EB + (size_t)16 * NCH * DK * 4, WS_AM = WS_QT + (size_t)MP * QKD * 2;
constexpr size_t WS_MIX_END = WS_AM + (size_t)512 * 4096 * 2;
constexpr size_t WS_H = WS_R, WS_FFN_END = WS_H + (size_t)MPAD * DFF * 2;
constexpr size_t WS_REND = WS_FFN_END > WS_MIX_END ? WS_FFN_END : WS_MIX_END;
constexpr int PRSW = 6400, NSP1 = 4;
constexpr size_t WS_PRS = WS_REND, WS_GLRP = WS_PRS + (size_t)8 * NS * PRSW * 4, WS_XSP = WS_GLRP + (size_t)8 * MPAD * RANK * 4, WS_END = WS_XSP + (size_t)11 * NS * DM * 4;
constexpr size_t WS_BAR = WS_END;
constexpr size_t WS_SS = WS_BAR + 16384, WS_SSP = WS_SS + (size_t)4 * MPAD * 4, WS_TAIL = WS_SSP + (size_t)MP * 32 * 4, WS_HEAD = WS_TAIL + (size_t)132 * 2 * DFF * 4, WS_TOTAL = WS_HEAD + (size_t)132 * 4 * DFF * 4;
constexpr int LDS_BYTES = 147456, LDS_BARST = LDS_BYTES - 64, LDS_HALO = 131072 + 2048;

__device__ __forceinline__ float bf_lo(unsigned w) { return __uint_as_float(w << 16); }
__device__ __forceinline__ float bf_hi(unsigned w) { return __uint_as_float(w & 0xffff0000u); }
__device__ __forceinline__ float bf1(bf16_t h) { return __uint_as_float((unsigned)h << 16); }
__device__ __forceinline__ bf16_t f2bf(float f) { return (bf16_t)(cvt_pk_bf16(f, 0.f) & 0xffffu); }
__device__ __forceinline__ float silu_f(float x) { return x * __builtin_amdgcn_rcpf(1.f + __expf(-x)); }
__device__ __forceinline__ float logsig_f(float z) { return fminf(z, 0.f) - __logf(1.f + __expf(-fabsf(z))); }
__device__ __forceinline__ float wave_sum(float v) {
#pragma unroll
    for (int o = 1; o < 64; o <<= 1) v += __shfl_xor(v, o);
    return v;
}
#define LDS_WAIT() asm volatile("s_waitcnt lgkmcnt(0)" ::: "memory")

__device__ __forceinline__ void tr_item(const float* W, int ldw, int ncols_valid, int K, bf16_t* WT, int dst_row0, int src_col0, bool perm, int kb, LAS float* scr, int lane, const float* gk = nullptr) {
    const int k0 = 64 * kb; const int c = src_col0 + (lane & 31); const bool ok = c < ncols_valid;
    float tv[32];
#pragma unroll
    for (int i = 0; i < 32; ++i) { const int kk = 2 * i + (lane >> 5); tv[i] = ok ? W[(size_t)(k0 + kk) * ldw + c] : 0.f; }
#pragma unroll
    for (int i = 0; i < 32; ++i) { const int kk = 2 * i + (lane >> 5); scr[kk * 33 + (lane & 31)] = gk ? tv[i] * gk[k0 + kk] : tv[i]; }
    LDS_WAIT(); asm volatile("" ::: "memory");
    const int c8 = lane & 7;
#pragma unroll
    for (int j = 0; j < 4; ++j) { const int n = (lane >> 3) + 8 * j; const int sc = perm ? pg8::perm32(n) : n; const LAS float* s = scr + (8 * c8) * 33 + sc;
        u32x4 o; o.x = cvt_pk_bf16(s[0 * 33], s[1 * 33]); o.y = cvt_pk_bf16(s[2 * 33], s[3 * 33]); o.z = cvt_pk_bf16(s[4 * 33], s[5 * 33]); o.w = cvt_pk_bf16(s[6 * 33], s[7 * 33]);
        *(u32x4*)(WT + (size_t)(dst_row0 + n) * K + k0 + 8 * c8) = o; }
    LDS_WAIT(); asm volatile("" ::: "memory");
}
__device__ __forceinline__ void win_map(int g, int& src, int& nvalid, bool& perm) {
    const int tile = g >> 3, gi = g & 7; nvalid = INC;
    if (tile < 8) { perm = false; src = (gi < 4) ? (1024 + 128 * tile + 32 * gi) : (2048 + 128 * tile + 32 * (gi - 4)); }
    else if (tile < 12) { perm = true; src = 256 * (tile - 8) + 32 * gi; }
    else if (tile < 24) { perm = true; src = 3072 + 256 * (tile - 12) + 32 * gi; }
    else { perm = false; src = 6144; if (gi != 0) nvalid = 0; }
}
struct P0Desc { const float* src; size_t ldw; const float* gk; bf16_t* dst; int K; bool ok, perm; };
constexpr int P0_I_IN = 25 * 32, P0_I_OUT = 8 * 32, P0_I_UP = 44 * 32, P0_I_DN = 8 * 88, P0_I_L = P0_I_IN + P0_I_OUT + P0_I_UP + P0_I_DN;
struct P0Src { const float *w_in, *w_out, *w_up, *w_down, *g_mix, *g_ffn; bf16_t *WT_IN, *WT_OUT, *WT_UP, *WT_DN; };
__device__ __forceinline__ bool p0_decode(int it, const P0Src& t, int wid, int lane, P0Desc& d) {
    if (it >= 2 * P0_I_L) return false;
    const int l = it / P0_I_L; int rr = it - l * P0_I_L; const float* W; int ldw, nv, K, blk, kb, dg; bf16_t* WT; bool perm; const float* gk = nullptr;
    if (rr < P0_I_IN) { blk = rr >> 5; kb = rr & 31; const int sg = blk * 8 + wid; W = t.w_in + (size_t)l * DM * INC; ldw = INC; nv = INC; K = DM; WT = t.WT_IN + (size_t)l * INP * DM; gk = t.g_mix + (size_t)l * DM;
        if (sg < 32) { dg = 64 + sg; perm = true; } else if (sg < 64) { const int q = sg - 32; dg = (q >> 2) * 8 + (q & 3); perm = true; } else if (sg < 96) { const int q = sg - 64; dg = (q >> 2) * 8 + 4 + (q & 3); perm = true; }
        else { dg = sg; perm = sg < 192; } }
    else if ((rr -= P0_I_IN) < P0_I_OUT) { blk = rr >> 5; kb = rr & 31; dg = blk * 8 + wid; perm = true; W = t.w_out + (size_t)l * DM * DM; ldw = DM; nv = DM; K = DM; WT = t.WT_OUT + (size_t)l * DM * DM; }
    else if ((rr -= P0_I_OUT) < P0_I_UP) { blk = rr >> 5; kb = rr & 31; const int sg = blk * 8 + wid; perm = true; W = t.w_up + (size_t)l * DM * UPN; ldw = UPN; nv = UPN; K = DM; WT = t.WT_UP + (size_t)l * UPN * DM; gk = t.g_ffn + (size_t)l * DM;
        if (sg < 176) dg = (sg >> 2) * 8 + (sg & 3); else { const int q = sg - 176; dg = (q >> 2) * 8 + 4 + (q & 3); } }
    else { rr -= P0_I_UP; blk = rr / 88; kb = rr - blk * 88; dg = blk * 8 + wid; perm = true; W = t.w_down + (size_t)l * DFF * DM; ldw = DM; nv = DM; K = DFF; WT = t.WT_DN + (size_t)l * DM * DFF; }
    const int k0 = 64 * kb, c = blk * 256 + 4 * lane;
    d.ok = c < nv; d.src = W + (size_t)(k0 + wid * 8) * ldw + c; d.ldw = (size_t)ldw; d.gk = gk ? gk + k0 + wid * 8 : nullptr; d.dst = WT + (size_t)(dg * 32) * K + k0; d.K = K; d.perm = perm; return true;
}
__device__ __forceinline__ void p0_load(const P0Desc& d, f32x4 (&tv)[8]) {
#pragma unroll
    for (int i = 0; i < 8; ++i) tv[i] = d.ok ? *(const f32x4*)(d.src + (size_t)i * d.ldw) : (f32x4){0.f, 0.f, 0.f, 0.f};
}
__device__ __forceinline__ void p0_to_lds(const P0Desc& d, const f32x4 (&tv)[8], LAS float* T, int wid, int lane) {
#pragma unroll
    for (int i = 0; i < 8; ++i) { const float g = d.gk ? d.gk[i] : 1.f; LAS float* tp = T + (wid * 8 + i) * 257 + 4 * lane; tp[0] = tv[i].x * g; tp[1] = tv[i].y * g; tp[2] = tv[i].z * g; tp[3] = tv[i].w * g; }
}
__device__ __forceinline__ void p0_out(const P0Desc& d, const LAS float* T, int wid, int lane) {
    const int c8 = lane & 7;
#pragma unroll
    for (int j = 0; j < 4; ++j) { const int n = (lane >> 3) + 8 * j; const int sc = d.perm ? pg8::perm32(n) : n; const LAS float* sp = T + (8 * c8) * 257 + 32 * wid + sc;
        u32x4 o; o.x = cvt_pk_bf16(sp[0 * 257], sp[1 * 257]); o.y = cvt_pk_bf16(sp[2 * 257], sp[3 * 257]); o.z = cvt_pk_bf16(sp[4 * 257], sp[5 * 257]); o.w = cvt_pk_bf16(sp[6 * 257], sp[7 * 257]);
        *(u32x4*)(d.dst + (size_t)n * d.K + 8 * c8) = o; }
}
__device__ __forceinline__ void rms_row_bf16(const float* xrow, const float* g, bf16_t* orow, int lane) {
    const f32x4* xr = (const f32x4*)xrow + lane; f32x4 v[8]; float s = 0.f;
#pragma unroll
    for (int j = 0; j < 8; ++j) { v[j] = xr[64 * j]; s += (v[j].x * v[j].x + v[j].y * v[j].y) + (v[j].z * v[j].z + v[j].w * v[j].w); }
    const float rstd = rsqrtf(wave_sum(s) * (1.f / DM) + EPS);
    const f32x4* gr = (const f32x4*)g + lane; u32x2* o8 = (u32x2*)orow + lane;
#pragma unroll
    for (int j = 0; j < 8; ++j) { const f32x4 gg = gr[64 * j]; u32x2 w; w.x = cvt_pk_bf16(v[j].x * rstd * gg.x, v[j].y * rstd * gg.y); w.y = cvt_pk_bf16(v[j].z * rstd * gg.z, v[j].w * rstd * gg.w); o8[64 * j] = w; }
}
__device__ __forceinline__ void row_bf16_ss(const float* xrow, bf16_t* orow, float* ss, int lane) {
    const f32x4* xr = (const f32x4*)xrow + lane; f32x4 v[8]; float s = 0.f;
#pragma unroll
    for (int j = 0; j < 8; ++j) { v[j] = xr[64 * j]; s += (v[j].x * v[j].x + v[j].y * v[j].y) + (v[j].z * v[j].z + v[j].w * v[j].w); }
    s = wave_sum(s); u32x2* o8 = (u32x2*)orow + lane;
#pragma unroll
    for (int j = 0; j < 8; ++j) { u32x2 w; w.x = cvt_pk_bf16(v[j].x, v[j].y); w.y = cvt_pk_bf16(v[j].z, v[j].w); o8[64 * j] = w; }
    if (lane == 0) *ss = s;
}
__device__ __forceinline__ void rms_row2_bf16(const float* xa, const float* xb, const float* g, bf16_t* oa, bf16_t* ob, int lane) {
    const f32x4* ra = (const f32x4*)xa + lane; const f32x4* rb = (const f32x4*)xb + lane; f32x4 va[8], vb[8]; float sa = 0.f, sb = 0.f;
#pragma unroll
    for (int j = 0; j < 8; ++j) { va[j] = ra[64 * j]; vb[j] = rb[64 * j]; }
#pragma unroll
    for (int j = 0; j < 8; ++j) { sa += (va[j].x * va[j].x + va[j].y * va[j].y) + (va[j].z * va[j].z + va[j].w * va[j].w); sb += (vb[j].x * vb[j].x + vb[j].y * vb[j].y) + (vb[j].z * vb[j].z + vb[j].w * vb[j].w); }
    const float rsa = rsqrtf(wave_sum(sa) * (1.f / DM) + EPS), rsb = rsqrtf(wave_sum(sb) * (1.f / DM) + EPS);
    const f32x4* gr = (const f32x4*)g + lane; u32x2* pa = (u32x2*)oa + lane; u32x2* pb = (u32x2*)ob + lane;
#pragma unroll
    for (int j = 0; j < 8; ++j) { const f32x4 gg = gr[64 * j]; u32x2 w;
        w.x = cvt_pk_bf16(va[j].x * rsa * gg.x, va[j].y * rsa * gg.y); w.y = cvt_pk_bf16(va[j].z * rsa * gg.z, va[j].w * rsa * gg.w); pa[64 * j] = w;
        w.x = cvt_pk_bf16(vb[j].x * rsb * gg.x, vb[j].y * rsb * gg.y); w.y = cvt_pk_bf16(vb[j].z * rsb * gg.z, vb[j].w * rsb * gg.w); pb[64 * j] = w; }
}
__device__ __forceinline__ void rms_row_f32(const float* xrow, const float* g, float* orow, int lane) {
    const f32x4* xr = (const f32x4*)xrow + lane; f32x4 v[8]; float s = 0.f;
#pragma unroll
    for (int j = 0; j < 8; ++j) { v[j] = xr[64 * j]; s += (v[j].x * v[j].x + v[j].y * v[j].y) + (v[j].z * v[j].z + v[j].w * v[j].w); }
    const float rstd = rsqrtf(wave_sum(s) * (1.f / DM) + EPS);
    const f32x4* gr = (const f32x4*)g + lane; f32x4* o = (f32x4*)orow + lane;
#pragma unroll
    for (int j = 0; j < 8; ++j) { const f32x4 gg = gr[64 * j]; o[64 * j] = v[j] * rstd * gg; }
}

struct EpiIn {
    static constexpr bool PERM = false, AFTER_DRAIN = false;
    bf16_t* PR; float* UC; float* GLRP; float* PRS; const float* SS; float* conv_p;
    __device__ __forceinline__ void operator()(const f32x4 (&acc)[2][2][4][2], const pg8::Unit& u, int wr, int wc, int fr, int fq) const {
        asm volatile("" : "+v"(fr), "+v"(fq), "+s"(wr), "+s"(wc));
        const int row0 = u.pm * 256 + wr * 64 + fr;
        float rs[2][4];
#pragma unroll
        for (int ai = 0; ai < 2; ++ai)
#pragma unroll
            for (int m = 0; m < 4; ++m) rs[ai][m] = rsqrtf(SS[row0 + ai * 128 + m * 16] * (1.f / DM) + EPS);
        if (u.pn == 24) {
            if (wc == 0) {
#pragma unroll
                for (int ai = 0; ai < 2; ++ai)
#pragma unroll
                    for (int m = 0; m < 4; ++m) *(f32x4*)(GLRP + ((size_t)u.sp * MPAD + row0 + ai * 128 + m * 16) * RANK + 4 * fq) = acc[ai][0][m][0] * rs[ai][m];
            }
        } else if (u.sp >= 0) {
            float* rp0 = PRS + ((size_t)u.sp * NS + wr * 64 + fr) * PRSW;
            if (u.pn < 8) {
#pragma unroll
                for (int m = 0; m < 4; ++m) { float* rp = rp0 + (size_t)(m * 16) * PRSW + 1024 + u.pn * 128 + wc * 32 + 8 * fq;
#pragma unroll
                    for (int bj = 0; bj < 2; ++bj)
#pragma unroll
                        for (int n = 0; n < 2; ++n) *(f32x4*)(rp + bj * 1024 + 4 * n) = acc[0][bj][m][n] * rs[0][m]; }
            } else { const int cb = (u.pn < 12 ? 256 * (u.pn - 8) : 3072 + 256 * (u.pn - 12)) + wc * 32 + 8 * fq;
#pragma unroll
                for (int m = 0; m < 4; ++m) { float* rp = rp0 + (size_t)(m * 16) * PRSW + cb;
#pragma unroll
                    for (int bj = 0; bj < 2; ++bj)
#pragma unroll
                        for (int n = 0; n < 2; ++n) *(f32x4*)(rp + bj * 128 + 4 * n) = acc[0][bj][m][n] * rs[0][m]; }
            }
        } else if (u.pn < 8) {
#pragma unroll
            for (int ai = 0; ai < 2; ++ai)
#pragma unroll
                for (int m = 0; m < 4; ++m) { const int row = row0 + ai * 128 + m * 16, cc = u.pn * 128 + wc * 32 + 8 * fq; bf16_t* rp = (bf16_t*)UC + (size_t)row * CONVD + cc; const float r2 = rs[ai][m] * rs[ai][m]; const int p = row & (SEQ - 1);
                    const f32x4 u0 = acc[ai][0][m][0] * acc[ai][1][m][0] * r2, u1 = acc[ai][0][m][1] * acc[ai][1][m][1] * r2; u32x4 w;
                    w.x = cvt_pk_bf16(u0.x, u0.y); w.y = cvt_pk_bf16(u0.z, u0.w); w.z = cvt_pk_bf16(u1.x, u1.y); w.w = cvt_pk_bf16(u1.z, u1.w); EPI_ST((u32x4*)rp, w);
                    if (p >= SEQ - 2) { float* sp = conv_p + ((size_t)(row >> 11) * 2 + (p - (SEQ - 2))) * CONVD + cc; *(f32x4*)sp = u0; *(f32x4*)(sp + 4) = u1; } }
        } else {
#pragma unroll
            for (int ai = 0; ai < 2; ++ai)
#pragma unroll
                for (int m = 0; m < 4; ++m) { bf16_t* rp = PR + (size_t)(row0 + ai * 128 + m * 16) * PRW + (u.pn - 8) * 256 + wc * 32 + 8 * fq; const float r1 = rs[ai][m];
#pragma unroll
                    for (int bj = 0; bj < 2; ++bj) { const f32x4 v0 = acc[ai][bj][m][0] * r1, v1 = acc[ai][bj][m][1] * r1; u32x4 w;
                        w.x = cvt_pk_bf16(v0[0], v0[1]); w.y = cvt_pk_bf16(v0[2], v0[3]); w.z = cvt_pk_bf16(v1[0], v1[1]); w.w = cvt_pk_bf16(v1[2], v1[3]);
                        EPI_ST((u32x4*)(rp + bj * 128), w); } }
        }
    }
};
template <int N> __device__ __forceinline__ float ror16(float v) { return __int_as_float(__builtin_amdgcn_update_dpp(0, __float_as_int(v), 0x120 + N, 0xF, 0xF, false)); }
struct EpiUp {
    static constexpr bool PERM = false, AFTER_DRAIN = false;
    bf16_t* H; const float* cw; const float* cb; float* TAIL; float* HEAD; const float* st_in; float* ffn_p; float* ffn_s; LAS float* halo; const float* SS;
    __device__ __forceinline__ void operator()(const f32x4 (&acc)[2][2][4][2], const pg8::Unit& u, int wr, int wc, int fr, int fq) const {
        asm volatile("" : "+v"(fr), "+v"(fq), "+s"(wr), "+s"(wc));
        const int col = u.pn * 128 + wc * 32 + 8 * fq; const int lc = wc * 32 + 8 * fq;
        if (u.pm == 32) {
            if (!RUN_FIX) __builtin_amdgcn_s_barrier();
#pragma unroll
            for (int n = 0; n < 2; ++n) { const int cn = col + 4 * n;
                const f32x4 w0 = *(const f32x4*)(cw + cn), w1 = *(const f32x4*)(cw + DFF + cn), w2 = *(const f32x4*)(cw + 2 * DFF + cn), bb = *(const f32x4*)(cb + cn);
#pragma unroll
                for (int m = 0; m < 4; ++m) { const int s = wr * 64 + m * 16 + fr; const float* sp = st_in + (size_t)s * 2 * DFF + cn; float* op = ffn_s + (size_t)s * 2 * DFF + cn;
                    const float r1 = rsqrtf(SS[MP + s] * (1.f / DM) + EPS);
                    const f32x4 s0 = *(const f32x4*)sp, s1 = *(const f32x4*)(sp + DFF), uu = acc[0][0][m][n] * r1, vv = acc[0][1][m][n] * r1;
                    *(f32x4*)op = s1; *(f32x4*)(op + DFF) = uu;
                    const f32x4 cu = s0 * w0 + s1 * w1 + uu * w2 + bb; u32x2 hw;
                    hw.x = cvt_pk_bf16(silu_f(cu[0]) * vv[0], silu_f(cu[1]) * vv[1]); hw.y = cvt_pk_bf16(silu_f(cu[2]) * vv[2], silu_f(cu[3]) * vv[3]);
                    *(u32x2*)(H + (size_t)(MP + s) * DFF + cn) = hw; *(u32x2*)(H + (size_t)(MP + 128 + s) * DFF + cn) = (u32x2){0u, 0u}; }
                asm volatile("" ::: "memory"); }
            return;
        }
        const int row0 = u.pm * 256 + wr * 64 + fr;
        float rs[2][4];
#pragma unroll
        for (int ai = 0; ai < 2; ++ai)
#pragma unroll
            for (int m = 0; m < 4; ++m) rs[ai][m] = rsqrtf(SS[row0 + ai * 128 + m * 16] * (1.f / DM) + EPS);
        if (!RUN_FIX) {
        if (fr >= 14) {
#pragma unroll
            for (int ai = 0; ai < 2; ++ai)
#pragma unroll
                for (int n = 0; n < 2; ++n) *(LAS f32x4*)(halo + ((2 * ai + wr) * 2 + (fr - 14)) * 128 + lc + 4 * n) = acc[ai][0][3][n] * rs[ai][3];
        }
        asm volatile("s_waitcnt lgkmcnt(0)" ::: "memory"); __builtin_amdgcn_s_barrier(); asm volatile("" ::: "memory");
        }
        u32x2 hkeep[2][4];
#pragma unroll
        for (int n = 0; n < 2; ++n) { const int cn = col + 4 * n;
            const f32x4 w0 = *(const f32x4*)(cw + cn), w1 = *(const f32x4*)(cw + DFF + cn), w2 = *(const f32x4*)(cw + 2 * DFF + cn), bb = *(const f32x4*)(cb + cn);
#pragma unroll
            for (int ai = 0; ai < 2; ++ai) {
                const int rho = 2 * ai + wr; const f32x4 z = {0.f, 0.f, 0.f, 0.f};
                const f32x4 h0 = (!RUN_FIX && rho > 0) ? *(const LAS f32x4*)(halo + ((rho - 1) * 2 + 0) * 128 + lc + 4 * n) : z, h1 = (!RUN_FIX && rho > 0) ? *(const LAS f32x4*)(halo + ((rho - 1) * 2 + 1) * 128 + lc + 4 * n) : z;
                f32x4 pu = {0.f, 0.f, 0.f, 0.f};
#pragma unroll
                for (int m = 0; m < 4; ++m) { const f32x4 uu = acc[ai][0][m][n] * rs[ai][m], vv = acc[ai][1][m][n] * rs[ai][m]; f32x4 p1, p2;
#pragma unroll
                    for (int e = 0; e < 4; ++e) { const float c1 = ror16<1>(uu[e]), c2 = ror16<2>(uu[e]); float q1, q2;
                        if (m > 0) { q1 = ror16<1>(pu[e]); q2 = ror16<2>(pu[e]); }
                        else { q1 = h1[e]; q2 = fr == 1 ? h1[e] : h0[e]; }
                        p1[e] = fr >= 1 ? c1 : q1; p2[e] = fr >= 2 ? c2 : q2; }
                    const f32x4 cu = p2 * w0 + p1 * w1 + uu * w2 + bb; u32x2 hw;
                    hw.x = cvt_pk_bf16(silu_f(cu[0]) * vv[0], silu_f(cu[1]) * vv[1]); hw.y = cvt_pk_bf16(silu_f(cu[2]) * vv[2], silu_f(cu[3]) * vv[3]);
                    if (n == 0) hkeep[ai][m] = hw; else { u32x4 h4; h4.x = hkeep[ai][m].x; h4.y = hkeep[ai][m].y; h4.z = hw.x; h4.w = hw.y; EPI_ST((u32x4*)(H + (size_t)(row0 + ai * 128 + m * 16) * DFF + col), h4); } pu = uu;
                    if (RUN_FIX) { const int R = u.pm * 4 + rho;
                        if (m == 3 && fr >= 14) { *(f32x4*)(TAIL + ((size_t)R * 2 + (fr - 14)) * DFF + cn) = uu; if ((R & 31) == 31) *(f32x4*)(ffn_p + ((size_t)(R >> 5) * 2 + (fr - 14)) * DFF + cn) = uu; }
                        if (m == 0 && fr < 2) { float* hp = HEAD + ((size_t)R * 2 + fr) * 2 * DFF + cn; *(f32x4*)hp = uu; *(f32x4*)(hp + DFF) = vv; } } }
            }
            asm volatile("" ::: "memory"); }
        if (!RUN_FIX && wr == 1 && fr >= 14) {
            const f32x4 t0 = acc[1][0][3][0] * rs[1][3], t1 = acc[1][0][3][1] * rs[1][3];
            float* tp = TAIL + ((size_t)u.pm * 2 + (fr - 14)) * DFF + col; *(f32x4*)tp = t0; *(f32x4*)(tp + 4) = t1;
            if ((u.pm & 7) == 7) { float* sp = ffn_p + ((size_t)(u.pm >> 3) * 2 + (fr - 14)) * DFF + col; *(f32x4*)sp = t0; *(f32x4*)(sp + 4) = t1; }
        }
        if (!RUN_FIX && wr == 0 && fr < 2) {
            float* hp = HEAD + ((size_t)u.pm * 2 + fr) * 2 * DFF + col; const float r1 = rs[0][0]; *(f32x4*)hp = acc[0][0][0][0] * r1; *(f32x4*)(hp + 4) = acc[0][0][0][1] * r1; *(f32x4*)(hp + DFF) = acc[0][1][0][0] * r1; *(f32x4*)(hp + DFF + 4) = acc[0][1][0][1] * r1;
        }
    }
};
struct EpiRes {
    static constexpr bool PERM = false, AFTER_DRAIN = false;
    const float* baseP; float* out; float* XSP; bf16_t* XB; float* SS;
    __device__ __forceinline__ void operator()(const f32x4 (&acc)[2][2][4][2], const pg8::Unit& u, int wr, int wc, int fr, int fq) const {
        asm volatile("" : "+v"(fr), "+v"(fq), "+s"(wr), "+s"(wc));
        const int row0 = u.pm * 256 + wr * 64 + fr; const int col0 = u.pn * 256 + wc * 32 + 8 * fq;
        if (u.sp >= 0) {
#pragma unroll
            for (int m = 0; m < 4; ++m) { float* op = XSP + ((size_t)u.sp * NS + wr * 64 + m * 16 + fr) * DM + col0;
#pragma unroll
                for (int bj = 0; bj < 2; ++bj)
#pragma unroll
                    for (int n = 0; n < 2; ++n) *(f32x4*)(op + bj * 128 + 4 * n) = acc[0][bj][m][n]; }
            return;
        }
#pragma unroll
        for (int ai = 0; ai < 2; ++ai)
#pragma unroll
            for (int m = 0; m < 4; ++m) { const int row = row0 + ai * 128 + m * 16;
                { bf16_t* xb = XB + (size_t)row * DM + col0; float ss = 0.f;
#pragma unroll
                    for (int bj = 0; bj < 2; ++bj) { f32x4 b0, b1;
                        if (baseP) { const float* bp = baseP + (size_t)row * DM + col0 + bj * 128; b0 = *(const f32x4*)bp; b1 = *(const f32x4*)(bp + 4); }
                        else { const u32x4 bw = *(const u32x4*)(xb + bj * 128); b0 = (f32x4){bf_lo(bw.x), bf_hi(bw.x), bf_lo(bw.y), bf_hi(bw.y)}; b1 = (f32x4){bf_lo(bw.z), bf_hi(bw.z), bf_lo(bw.w), bf_hi(bw.w)}; }
                        const f32x4 v0 = b0 + acc[ai][bj][m][0], v1 = b1 + acc[ai][bj][m][1];
                        ss += ((v0.x * v0.x + v0.y * v0.y) + (v0.z * v0.z + v0.w * v0.w)) + ((v1.x * v1.x + v1.y * v1.y) + (v1.z * v1.z + v1.w * v1.w));
                        u32x4 w; w.x = cvt_pk_bf16(v0.x, v0.y); w.y = cvt_pk_bf16(v0.z, v0.w); w.z = cvt_pk_bf16(v1.x, v1.y); w.w = cvt_pk_bf16(v1.z, v1.w); EPI_ST((u32x4*)(xb + bj * 128), w); }
                    if (SS) { ss += __shfl_xor(ss, 16); ss += __shfl_xor(ss, 32); if (fq == 0) SS[(size_t)row * 32 + u.pn * 4 + wc] = ss; } }
                asm volatile("" ::: "memory"); }
    }
};

#define MFMA16(x, y, c) __builtin_amdgcn_mfma_f32_16x16x32_bf16((x), (y), (c), 0, 0, 0)
typedef short s16x4 __attribute__((ext_vector_type(4)));
template <int RS> __device__ __forceinline__ bf16x8 tr_frag(const LAS bf16_t* T, int c, int ks, int lane) {
#ifdef TR_GATHER
    const int g = lane >> 4; const LAS bf16_t* a0 = T + (32 * ks + 8 * g) * RS + 16 * c + (lane & 15); bf16x8 o;
#pragma unroll
    for (int j = 0; j < 8; ++j) o[j] = (short)a0[j * RS];
    return o;
#else
    const int g = lane >> 4, qq = (lane & 15) >> 2, p = lane & 3; const LAS bf16_t* a0 = T + (32 * ks + 8 * g + qq) * RS + 16 * c + 4 * p;
    unsigned addr = (unsigned)(size_t)a0; asm volatile("" : "+v"(addr));
    const LAS bf16_t* a1 = (const LAS bf16_t*)(size_t)addr;
    s16x4 t0 = __builtin_amdgcn_ds_read_tr16_b64_v4i16((LAS s16x4*)a1), t1 = __builtin_amdgcn_ds_read_tr16_b64_v4i16((LAS s16x4*)(a1 + 4 * RS));
    asm volatile("" : "+v"(t0), "+v"(t1) : "v"(addr));
    return __builtin_shufflevector(t0, t1, 0, 1, 2, 3, 4, 5, 6, 7);
#endif
}
__device__ __forceinline__ void stage_v(LAS bf16_t* Vn, const bf16_t* PR, int tok0, int h, int tid) {
#pragma unroll
    for (int i = 0; i < 4; ++i) { const int id = tid + 512 * i, j = id >> 5, cc = id & 31; *(LAS u32x4*)(Vn + j * 272 + cc * 8) = *(const u32x4*)(PR + (size_t)(tok0 + j) * PRW + 2048 + h * DV + cc * 8); }
}
__device__ __forceinline__ void gla_passA(LAS unsigned char* lds, int uidx, const bf16_t* PR, const float* GLRP, const float* w2, const float* gb,
                                          bf16_t* SUB, float* EB, bf16_t* QT, bf16_t* AM, int tid, int wid, int lane) {
    const int b = uidx >> 7, c = (uidx >> 2) & 31, h = uidx & 3; const int tok0 = b * SEQ + c * 64; const int bh = b * 4 + h;
    LAS float* Bc = (LAS float*)lds;
    LAS float* bCs = Bc + 64 * 129;
    LAS bf16_t* Qs = (LAS bf16_t*)(lds + 33536);
    LAS bf16_t* Ks = Qs + 64 * 136;
    LAS bf16_t* Kh = Ks + 64 * 136;
    LAS bf16_t* Vn = Kh + 64 * 136;
    const int r = lane & 15, q = lane >> 4;
    const bf16_t* qp = PR + (size_t)(tok0 + (tid >> 3)) * PRW + 1024 + h * DK + (tid & 7) * 16;
    const u32x4 qa = *(const u32x4*)qp, qb = *(const u32x4*)(qp + 8), ka = *(const u32x4*)(qp + 512), kb = *(const u32x4*)(qp + 520);
    u32x4 vreg[4];
#pragma unroll
    for (int i = 0; i < 4; ++i) { const int id = tid + 512 * i; vreg[i] = *(const u32x4*)(PR + (size_t)(tok0 + (id >> 5)) * PRW + 2048 + h * DV + (id & 31) * 8); }
    LAS float* Gs = (LAS float*)(lds + 120576);
    LAS float* Tt = Gs + 64 * 16;
    if (tid < 256) { const int t = tid >> 2, r4 = (tid & 3) * 4; const float* gp = GLRP + (size_t)(tok0 + t) * RANK + r4; f32x4 g = *(const f32x4*)gp;
#pragma unroll
        for (int sp = 1; sp < NSP1; ++sp) g += *(const f32x4*)(gp + (size_t)sp * MPAD * RANK);
        *(LAS f32x4*)(Gs + t * 16 + r4) = g; }
    const int kcol = tid & 127, tg = tid >> 7;
    float wk[16];
#pragma unroll
    for (int rr = 0; rr < 16; ++rr) wk[rr] = w2[rr * QKD + h * DK + kcol];
    const float bias = gb[h * DK + kcol];
#pragma unroll
    for (int i = 0; i < 4; ++i) { const int id = tid + 512 * i; *(LAS u32x4*)(Vn + (id >> 5) * 272 + (id & 31) * 8) = vreg[i]; }
    __syncthreads();
    { float run = 0.f;
#pragma unroll 4
      for (int i = 0; i < 16; ++i) { const int t = 16 * tg + i; const LAS f32x4* gr = (const LAS f32x4*)(Gs + t * 16); const f32x4 a0 = gr[0], a1 = gr[1], a2 = gr[2], a3 = gr[3];
          float z = bias;
          z += a0.x * wk[0] + a0.y * wk[1] + a0.z * wk[2] + a0.w * wk[3]; z += a1.x * wk[4] + a1.y * wk[5] + a1.z * wk[6] + a1.w * wk[7];
          z += a2.x * wk[8] + a2.y * wk[9] + a2.z * wk[10] + a2.w * wk[11]; z += a3.x * wk[12] + a3.y * wk[13] + a3.z * wk[14] + a3.w * wk[15];
          run += logsig_f(z) * (1.f / 16.f); Bc[t * 129 + kcol] = run; }
      Tt[tg * 128 + kcol] = run; }
    __syncthreads();
    {
        const int j = tid >> 3, kr = (tid & 7) * 16, jg = j >> 4;
        const float scale = 0.08838834764831845f;
        u32x4 oq[2], ok[2], oh[2];
#pragma unroll
        for (int e4 = 0; e4 < 4; ++e4) {
            const f32x4 t0 = *(const LAS f32x4*)(Tt + 0 * 128 + kr + 4 * e4), t1 = *(const LAS f32x4*)(Tt + 1 * 128 + kr + 4 * e4), t2 = *(const LAS f32x4*)(Tt + 2 * 128 + kr + 4 * e4), t3 = *(const LAS f32x4*)(Tt + 3 * 128 + kr + 4 * e4);
            const f32x4 zz = {0.f, 0.f, 0.f, 0.f}; const f32x4 off = (jg > 0 ? t0 : zz) + (jg > 1 ? t1 : zz) + (jg > 2 ? t2 : zz), bc = (t0 + t1) + (t2 + t3);
#pragma unroll
            for (int eh = 0; eh < 2; ++eh) { const int e2 = 2 * e4 + eh; const unsigned qw = e2 < 4 ? qa[e2] : qb[e2 - 4], kw = e2 < 4 ? ka[e2] : kb[e2 - 4];
                const int k = kr + 2 * e2;
                const float b0 = Bc[j * 129 + k] + off[2 * eh], b1 = Bc[j * 129 + k + 1] + off[2 * eh + 1], c0 = bc[2 * eh], c1 = bc[2 * eh + 1];
                const float q0 = bf_lo(qw) * scale * __expf(b0), q1 = bf_hi(qw) * scale * __expf(b1);
                const float k0 = bf_lo(kw), k1 = bf_hi(kw);
                const unsigned pq = cvt_pk_bf16(q0, q1), pk = cvt_pk_bf16(k0 * __expf(-b0), k1 * __expf(-b1)), ph = cvt_pk_bf16(k0 * __expf(c0 - b0), k1 * __expf(c1 - b1));
                if (e2 < 4) { oq[0][e2] = pq; ok[0][e2] = pk; oh[0][e2] = ph; } else { oq[1][e2 - 4] = pq; ok[1][e2 - 4] = pk; oh[1][e2 - 4] = ph; } }
        }
        *(LAS u32x4*)(Qs + j * 136 + kr) = oq[0]; *(LAS u32x4*)(Qs + j * 136 + kr + 8) = oq[1];
        *(LAS u32x4*)(Ks + j * 136 + kr) = ok[0]; *(LAS u32x4*)(Ks + j * 136 + kr + 8) = ok[1];
        *(LAS u32x4*)(Kh + j * 136 + kr) = oh[0]; *(LAS u32x4*)(Kh + j * 136 + kr + 8) = oh[1];
        bf16_t* qt = QT + (size_t)(tok0 + j) * QKD + h * DK + kr; *(u32x4*)qt = oq[0]; *(u32x4*)(qt + 8) = oq[1];
        if (tid < DK) EB[((size_t)bh * NCH + c) * DK + tid] = __expf((Tt[tid] + Tt[128 + tid]) + (Tt[256 + tid] + Tt[384 + tid]));
    }
    __syncthreads();
    {
        const int it = wid >> 1, jt0 = (wid & 1) * 2; f32x4 a[2] = {{0.f, 0.f, 0.f, 0.f}, {0.f, 0.f, 0.f, 0.f}};
#pragma unroll
        for (int ks = 0; ks < 4; ++ks) { const bf16x8 y = *(const LAS bf16x8*)(Qs + (16 * it + r) * 136 + 32 * ks + 8 * q);
#pragma unroll
            for (int jj = 0; jj < 2; ++jj) { const bf16x8 x = *(const LAS bf16x8*)(Ks + (16 * (jt0 + jj) + r) * 136 + 32 * ks + 8 * q); a[jj] = MFMA16(x, y, a[jj]); } }
        const int i = 16 * it + r;
#pragma unroll
        for (int jj = 0; jj < 2; ++jj) { const int jb = 16 * (jt0 + jj) + 4 * q; u32x2 w;
            w.x = cvt_pk_bf16(jb + 0 <= i ? a[jj][0] : 0.f, jb + 1 <= i ? a[jj][1] : 0.f); w.y = cvt_pk_bf16(jb + 2 <= i ? a[jj][2] : 0.f, jb + 3 <= i ? a[jj][3] : 0.f);
            *(u32x2*)(AM + (size_t)uidx * 4096 + i * 64 + jb) = w; }
    }
    {
        f32x4 acc[2][8];
#pragma unroll
        for (int a = 0; a < 2; ++a)
#pragma unroll
            for (int yt = 0; yt < 8; ++yt) acc[a][yt] = (f32x4){0.f, 0.f, 0.f, 0.f};
#pragma unroll
        for (int ks = 0; ks < 2; ++ks) { bf16x8 x[2];
#pragma unroll
            for (int a = 0; a < 2; ++a) x[a] = tr_frag<272>(Vn, 2 * wid + a, ks, lane);
#pragma unroll
            for (int yt = 0; yt < 8; ++yt) { const bf16x8 y = tr_frag<136>(Kh, yt, ks, lane);
#pragma unroll
                for (int a = 0; a < 2; ++a) acc[a][yt] = MFMA16(x[a], y, acc[a][yt]); } }
        bf16_t* sp = SUB + ((size_t)bh * NCH + c) * (DK * DV);
#pragma unroll
        for (int a = 0; a < 2; ++a)
#pragma unroll
            for (int yt = 0; yt < 8; ++yt) { u32x2 w; w.x = cvt_pk_bf16(acc[a][yt][0], acc[a][yt][1]); w.y = cvt_pk_bf16(acc[a][yt][2], acc[a][yt][3]); *(u32x2*)(sp + (16 * yt + r) * DV + 32 * wid + 16 * a + 4 * q) = w; }
    }
    __syncthreads();
}
__device__ __forceinline__ void gla_passC(LAS unsigned char* lds, int uidx, const bf16_t* PR, const bf16_t* SUB, const bf16_t* QT, const bf16_t* AM, const float* gn  ,
                                          bf16_t* Y, int tid, int wid, int lane) {
    const int b = uidx >> 7, c = (uidx >> 2) & 31, h = uidx & 3; const int tok0 = b * SEQ + c * 64; const int bh = b * 4 + h;
    LAS bf16_t* Qs = (LAS bf16_t*)lds;
    LAS bf16_t* As = (LAS bf16_t*)(lds + 17408);
    LAS bf16_t* Vn = (LAS bf16_t*)(lds + 26624);
    LAS bf16_t* Sn = (LAS bf16_t*)(lds + 61440);
    LAS float* Of = (LAS float*)(lds + 61440);
    const int r = lane & 15, q = lane >> 4;
    u32x4 ogr[4];
    { const bf16_t* gp0 = PR + (size_t)(tok0 + (tid >> 3)) * PRW + 3072 + h * DV + (tid & 7) * 32;
#pragma unroll
      for (int j = 0; j < 4; ++j) ogr[j] = *(const u32x4*)(gp0 + 8 * j); }
    { const bf16_t* sp = SUB + ((size_t)bh * NCH + c) * (DK * DV);
#pragma unroll
      for (int i = 0; i < 8; ++i) { const int id = tid + 512 * i, k = id >> 5, cc = id & 31; *(LAS u32x4*)(Sn + k * 272 + cc * 8) = *(const u32x4*)(sp + k * DV + cc * 8); } }
#pragma unroll
    for (int i = 0; i < 2; ++i) { const int id = tid + 512 * i, row = id >> 4, cc = id & 15; *(LAS u32x4*)(Qs + row * 136 + cc * 8) = *(const u32x4*)(QT + (size_t)(tok0 + row) * QKD + h * DK + cc * 8); }
    { const int row = tid >> 3, cc = tid & 7; *(LAS u32x4*)(As + row * 72 + cc * 8) = *(const u32x4*)(AM + (size_t)uidx * 4096 + row * 64 + cc * 8); }
    stage_v(Vn, PR, tok0, h, tid);
    __syncthreads();
    f32x4 acc[2][4];
#pragma unroll
    for (int a = 0; a < 2; ++a)
#pragma unroll
        for (int it = 0; it < 4; ++it) acc[a][it] = (f32x4){0.f, 0.f, 0.f, 0.f};
#pragma unroll
    for (int ks = 0; ks < 4; ++ks) { bf16x8 x[2];
#pragma unroll
        for (int a = 0; a < 2; ++a) x[a] = tr_frag<272>(Sn, 2 * wid + a, ks, lane);
#pragma unroll
        for (int it = 0; it < 4; ++it) { const bf16x8 y = *(const LAS bf16x8*)(Qs + (16 * it + r) * 136 + 32 * ks + 8 * q);
#pragma unroll
            for (int a = 0; a < 2; ++a) acc[a][it] = MFMA16(x[a], y, acc[a][it]); } }
#pragma unroll
    for (int ks = 0; ks < 2; ++ks) { bf16x8 x[2];
#pragma unroll
        for (int a = 0; a < 2; ++a) x[a] = tr_frag<272>(Vn, 2 * wid + a, ks, lane);
#pragma unroll
        for (int it = 0; it < 4; ++it) { const bf16x8 y = *(const LAS bf16x8*)(As + (16 * it + r) * 72 + 32 * ks + 8 * q);
#pragma unroll
            for (int a = 0; a < 2; ++a) acc[a][it] = MFMA16(x[a], y, acc[a][it]); } }
    __syncthreads();
#pragma unroll
    for (int a = 0; a < 2; ++a)
#pragma unroll
        for (int it = 0; it < 4; ++it) *(LAS f32x4*)(Of + (16 * it + r) * 260 + 32 * wid + 16 * a + 4 * q) = acc[a][it];
    __syncthreads();
    { const int i = tid >> 3, seg = tid & 7; f32x4 o[8]; float ss = 0.f;
#pragma unroll
      for (int j = 0; j < 8; ++j) { o[j] = *(const LAS f32x4*)(Of + i * 260 + seg * 32 + 4 * j); ss += (o[j].x * o[j].x + o[j].y * o[j].y) + (o[j].z * o[j].z + o[j].w * o[j].w); }
      ss += __shfl_xor(ss, 1); ss += __shfl_xor(ss, 2); ss += __shfl_xor(ss, 4);
      const float rstd = rsqrtf(ss * (1.f / DV) + EPS);
      const bf16_t* gp = PR + (size_t)(tok0 + i) * PRW + 3072 + h * DV + seg * 32; const float* gnp = gn + h * DV + seg * 32; bf16_t* yp = Y + (size_t)(tok0 + i) * DM + 1024 + h * DV + seg * 32;
#pragma unroll
      for (int j = 0; j < 4; ++j) { const u32x4 g = ogr[j]; const f32x4 n0 = *(const f32x4*)(gnp + 8 * j), n1 = *(const f32x4*)(gnp + 8 * j + 4); const f32x4 a0 = o[2 * j], a1 = o[2 * j + 1]; u32x4 w;
          w.x = cvt_pk_bf16(a0.x * rstd * n0.x * silu_f(bf_lo(g.x)), a0.y * rstd * n0.y * silu_f(bf_hi(g.x)));
          w.y = cvt_pk_bf16(a0.z * rstd * n0.z * silu_f(bf_lo(g.y)), a0.w * rstd * n0.w * silu_f(bf_hi(g.y)));
          w.z = cvt_pk_bf16(a1.x * rstd * n1.x * silu_f(bf_lo(g.z)), a1.y * rstd * n1.y * silu_f(bf_hi(g.z)));
          w.w = cvt_pk_bf16(a1.z * rstd * n1.z * silu_f(bf_lo(g.w)), a1.w * rstd * n1.w * silu_f(bf_hi(g.w)));
          *(u32x4*)(yp + 8 * j) = w; } }
    __syncthreads();
}
__device__ __forceinline__ float prs_sum(const float* PRS, int s, int col) { float v = 0.f;
#pragma unroll
    for (int sp = 0; sp < NSP1; ++sp) v += PRS[((size_t)sp * NS + s) * PRSW + col];
    return v; }
__device__ __forceinline__ f32x4 prs_sum4(const float* PRS, int s, int col) { f32x4 v = {0.f, 0.f, 0.f, 0.f};
#pragma unroll
    for (int sp = 0; sp < NSP1; ++sp) v += *(const f32x4*)(PRS + ((size_t)sp * NS + s) * PRSW + col);
    return v; }
template <bool WITH_O> __device__ __forceinline__ void gla_sample(LAS unsigned char* lds, int uidx, const float* PRS, const float* GLRP, const float* w2, const float* gb, const float* gn,
                                           const float* s_in  , float* s_out  , bf16_t* Y, int tid, int wid, int lane) {
    const int s = uidx >> 2, h = uidx & 3; const int row = MP + s;
    LAS float* smA = (LAS float*)lds; LAS float* smK = smA + 128; LAS float* smQ = smK + 128; LAS float* smO = smQ + 128; LAS float* smR = smO + 2048;
    const size_t sb = ((size_t)(s * 4 + h) * DK) * DV + (tid & 63) * 4; f32x4 S[16];
#pragma unroll
    for (int kk = 0; kk < 16; ++kk) S[kk] = __builtin_nontemporal_load((const f32x4*)(s_in + sb + (size_t)(16 * wid + kk) * DV));
    if (tid < DK) { const int col = h * DK + tid; float z = gb[col];
#pragma unroll
        for (int rr = 0; rr < RANK; ++rr) { float g = 0.f;
#pragma unroll
            for (int sp = 0; sp < NSP1; ++sp) g += GLRP[((size_t)sp * MPAD + row) * RANK + rr];
            z += g * w2[rr * QKD + col]; }
        smA[tid] = __expf(logsig_f(z) * (1.f / 16.f)); smK[tid] = prs_sum(PRS, s, 3584 + col); if (WITH_O) smQ[tid] = prs_sum(PRS, s, 3072 + col) * 0.08838834764831845f; }
    const int dv4 = (tid & 63) * 4; const f32x4 v = prs_sum4(PRS, s, 4096 + h * DV + dv4);
    __syncthreads();
    f32x4 o = {0.f, 0.f, 0.f, 0.f};
#pragma unroll
    for (int kk = 0; kk < 16; ++kk) { const int k = 16 * wid + kk; const f32x4 sn = S[kk] * smA[k] + v * smK[k]; if (!WITH_O || !DEFER_STATE) __builtin_nontemporal_store(sn, (f32x4*)(s_out + sb + (size_t)k * DV)); if (WITH_O) o += sn * smQ[k]; }
    if (!WITH_O) { __syncthreads(); return; }
    *(LAS f32x4*)(smO + wid * 256 + dv4) = o;
    __syncthreads();
    float oo = 0.f;
    if (tid < 256) {
#pragma unroll
        for (int w = 0; w < 8; ++w) oo += smO[w * 256 + tid];
        const float ss = wave_sum(oo * oo); if (lane == 0) smR[wid] = ss; }
    __syncthreads();
    if (tid < 256) { const float tot = (smR[0] + smR[1]) + (smR[2] + smR[3]); const float rstd = rsqrtf(tot * (1.f / DV) + EPS);
        const float og = prs_sum(PRS, s, 5120 + h * DV + tid); Y[(size_t)row * DM + 1024 + h * DV + tid] = f2bf(oo * rstd * gn[h * DV + tid] * silu_f(og)); }
    __syncthreads();
}
__device__ __forceinline__ void sample_assemble(const float* base, const float* XSP, int nsp, int s, float* xr, int lane) {
    const f32x4* br = (const f32x4*)base + lane; f32x4* o = (f32x4*)xr + lane;
#pragma unroll
    for (int j = 0; j < 8; ++j) { f32x4 v = br[64 * j];
        for (int sp = 0; sp < nsp; ++sp) v += *((const f32x4*)(XSP + ((size_t)sp * NS + s) * DM) + lane + 64 * j);
        o[64 * j] = v; }
}

template <int PH> struct MixOrder {
    pg8::StaticOrder so; int nfull, ntfull;
    __device__ __forceinline__ void init(int Ncols, int ntf, int G, int c) { so.init(MP, Ncols, G, c); nfull = so.nwg; ntfull = ntf; }
    __device__ __forceinline__ bool next(int i, pg8::Unit& u) const {
        const long L = (long)i * so.G + so.c; int pm = 32, pn = 0, sp = -1, k0 = 0, nt = ntfull; bool ok = true;
        if (L < nfull) { pg8::Unit t; so.next(i, t); pm = t.pm; pn = t.pn; }
        else { const int mi = (int)(L - nfull);
            if (PH == 1) { ok = mi < 57 * NSP1;
                const bool isg = mi < 33 * NSP1; const int m2 = isg ? mi : mi - 33 * NSP1; const int qd = m2 / NSP1; sp = m2 - qd * NSP1; pm = isg ? qd : 32; pn = isg ? 24 : qd; nt = 32 / NSP1; k0 = sp * (32 / NSP1); }
            else if (PH == 2) { ok = mi < 64; pn = mi >> 3; sp = mi & 7; k0 = sp * 4; nt = 4; }
            else if (PH == 3) { ok = mi < 44; pn = mi; nt = 32; }
            else { ok = mi < 88; pn = mi / 11; sp = mi - 11 * pn; k0 = sp * 8; nt = 8; }
        }
        u.pm = pm; u.pn = pn; u.sp = sp; u.k0 = k0; u.nt = nt; return ok;
    }
    __device__ __forceinline__ void a_ready(const pg8::Unit&) const {}
    __device__ __forceinline__ void done(const pg8::Unit&) const {}
};

#define XB_TMO      128
#define XB_XCNT(j)  (256  + 64 * (j))
#define XB_XSUB(j)  (1280 + 64 * (j))
#define XB_XGEN(j)  (2304 + 64 * (j))
#define XB_TOP      3328
#define XB_TOPGEN   3392
#define XCD_BAR_WORDS 3456
#define XB_SPIN_CAP (1u << 18)

__device__ __forceinline__ unsigned xb_ld(unsigned* p)              { return __hip_atomic_load(p, __ATOMIC_RELAXED, __HIP_MEMORY_SCOPE_AGENT); }
__device__ __forceinline__ unsigned xb_add(unsigned* p, unsigned v) { return __hip_atomic_fetch_add(p, v, __ATOMIC_RELAXED, __HIP_MEMORY_SCOPE_AGENT); }
__device__ __forceinline__ unsigned xb_xcc_id() { return (unsigned)__builtin_amdgcn_s_getreg((3 << 11) | 20) & 0xFu; }
#define XB_SPIN(cond, bar) do { unsigned _sp = 0; while (cond) { __builtin_amdgcn_s_sleep(1); \
    if ((++_sp & 255u) == 0u) { if (xb_ld(&(bar)[XB_TMO])) break; if (_sp > XB_SPIN_CAP) { atomicAdd(&(bar)[XB_TMO], 1u); break; } } } } while (0)

struct XcdBarrier {
    unsigned* bar; unsigned x;
    volatile LAS unsigned* st;
};

__device__ __forceinline__ XcdBarrier xcd_barrier_post(unsigned* bar, volatile LAS unsigned* st) {
    XcdBarrier b; b.bar = bar; b.x = xb_xcc_id(); b.st = st;
    if (threadIdx.x == 0) (void)xb_add(&bar[XB_XCNT(b.x)], 1u);
    return b;
}
__device__ __forceinline__ void xcd_barrier_complete(unsigned* bar, unsigned x, unsigned& nloc, unsigned& nx) {
    const unsigned G = gridDim.x * gridDim.y * gridDim.z;
    unsigned sum, cnt, mine, sp = 0u;
    for (;;) {
        sum = 0u; cnt = 0u; mine = 0u;
#pragma unroll
        for (unsigned j = 0; j < 16; ++j) { const unsigned c = xb_ld(&bar[XB_XCNT(j)]); sum += c; cnt += (c > 0u) ? 1u : 0u; mine = (j == x) ? c : mine; }
        if (sum == G) break;
        __builtin_amdgcn_s_sleep(1);
        if ((++sp & 255u) == 0u) { if (xb_ld(&bar[XB_TMO])) break; if (sp > XB_SPIN_CAP) { atomicAdd(&bar[XB_TMO], 1u); break; } }
    }
    nloc = mine > 0u ? mine : 1u; nx = cnt > 0u ? cnt : 1u;
}

__device__ __forceinline__ void xcd_barrier(const XcdBarrier& b) {
    asm volatile("s_waitcnt vmcnt(0)" ::: "memory");
    __syncthreads();
    if (threadIdx.x == 0) {
        unsigned* bar = b.bar;
        __builtin_amdgcn_s_waitcnt(0);
        unsigned nloc = b.st[0], nx = b.st[1];
        if (nloc == 0u) { xcd_barrier_complete(bar, b.x, nloc, nx); b.st[0] = nloc; b.st[1] = nx; }
        const unsigned old = xb_add(&bar[XB_XSUB(b.x)], 1u);
        const unsigned gen = old / nloc;
        if (old + 1u == (gen + 1u) * nloc) {
            __builtin_amdgcn_fence(__ATOMIC_RELEASE, "agent");
            asm volatile("s_waitcnt vmcnt(0)" ::: "memory");
            const unsigned og = xb_add(&bar[XB_TOP], 1u);
            const unsigned tg = og / nx;
            if (og + 1u == (tg + 1u) * nx) xb_add(&bar[XB_TOPGEN], 1u);
            else XB_SPIN(xb_ld(&bar[XB_TOPGEN]) == tg, bar);
            __builtin_amdgcn_fence(__ATOMIC_ACQUIRE, "agent");
            xb_add(&bar[XB_XGEN(b.x)], 1u);
            asm volatile("s_waitcnt vmcnt(0)" ::: "memory");
        } else {
            XB_SPIN(xb_ld(&bar[XB_XGEN(b.x)]) == gen, bar);
            __builtin_amdgcn_fence(__ATOMIC_ACQUIRE, "agent");
            asm volatile("s_waitcnt vmcnt(0)" ::: "memory");
        }
    }
    __syncthreads();
}

struct Args { const float* in[18]; float* out; unsigned char* ws; };
__global__ void __launch_bounds__(NTHR, 2) fwd_kernel(Args a) {
    extern __shared__ __attribute__((aligned(16))) unsigned char lds_raw[];
    LAS unsigned char* lds = (LAS unsigned char*)lds_raw;
    cg::grid_group grid = cg::this_grid();
    if (threadIdx.x < 2) ((volatile LAS unsigned*)(lds + LDS_BARST))[threadIdx.x] = 0u;
    if (a.ws == nullptr) grid.sync();
    { unsigned* bw = (unsigned*)(a.ws + WS_BAR); unsigned* rdy = bw + 4000;
      if (blockIdx.x == 0) { for (int i = threadIdx.x; i < XCD_BAR_WORDS; i += NTHR) __hip_atomic_store(bw + i, 0u, __ATOMIC_RELAXED, __HIP_MEMORY_SCOPE_AGENT);
          asm volatile("s_waitcnt vmcnt(0)" ::: "memory"); __syncthreads();
          if (threadIdx.x == 0) { __builtin_amdgcn_fence(__ATOMIC_RELEASE, "agent"); __hip_atomic_store(rdy, 0x5EEDBA55u, __ATOMIC_RELAXED, __HIP_MEMORY_SCOPE_AGENT); } }
      if (threadIdx.x == 0) { unsigned spins = 0u;
          while (__hip_atomic_load(rdy, __ATOMIC_RELAXED, __HIP_MEMORY_SCOPE_AGENT) != 0x5EEDBA55u && ++spins < (1u << 22)) __builtin_amdgcn_s_sleep(2);
          __builtin_amdgcn_fence(__ATOMIC_ACQUIRE, "agent");
          ((volatile LAS unsigned*)(lds + LDS_BARST + 16))[0] = xb_add(&bw[XB_XCNT(xb_xcc_id())], 1u); }
      __syncthreads(); }
    const int G = gridDim.x, bid = blockIdx.x; const int NGW = G * 8, NGT = G * NTHR;
#define PHASE_IDS KP_DECL int tid = threadIdx.x; asm volatile("" : "+v"(tid)); const int lane = tid & 63; const int wid = __builtin_amdgcn_readfirstlane(tid >> 6); const int gw = bid * 8 + wid; const int gt = bid * NTHR + tid; (void)gw; (void)gt; (void)lane;
    typedef const __attribute__((address_space(4))) unsigned char* kargp_t;
#define KP_DECL kargp_t kp_ = (kargp_t)__builtin_amdgcn_kernarg_segment_ptr(); asm volatile("" : "+s"(kp_));
#define KIN(i) (*(const __attribute__((address_space(4))) float* const __attribute__((address_space(4)))*)(kp_ + 8 * (i)))
#define KPTR(i) (*(unsigned char* const __attribute__((address_space(4)))*)(kp_ + 8 * (i)))
#define x_prompt ((const float*)KPTR(0))
#define x_sample ((const float*)KPTR(1))
#define state_conv ((const float*)KPTR(2))
#define state_gla ((const float*)KPTR(3))
#define state_ffn ((const float*)KPTR(4))
#define norm_mix_g ((const float*)KPTR(5))
#define w_in ((const float*)KPTR(6))
#define conv_w ((const float*)KPTR(7))
#define gate_w2 ((const float*)KPTR(8))
#define gate_b ((const float*)KPTR(9))
#define gla_norm_g ((const float*)KPTR(10))
#define w_out ((const float*)KPTR(11))
#define norm_ffn_g ((const float*)KPTR(12))
#define w_up ((const float*)KPTR(13))
#define ffn_conv_w ((const float*)KPTR(14))
#define ffn_conv_b ((const float*)KPTR(15))
#define w_down ((const float*)KPTR(16))
#define final_norm_g ((const float*)KPTR(17))
#define out ((float*)KPTR(18))
#define ws (KPTR(19))
#define WT_IN ((bf16_t*)(ws + WS_WIN))
#define WT_OUT ((bf16_t*)(ws + WS_WOUT))
#define WT_UP ((bf16_t*)(ws + WS_WUP))
#define WT_DN ((bf16_t*)(ws + WS_WDN))
#define XN ((bf16_t*)(ws + WS_XN))
#define XR ((float*)(ws + WS_XR))
#define PR ((bf16_t*)(ws + WS_PR))
#define UC ((float*)(ws + WS_UC))
#define Y ((bf16_t*)(ws + WS_Y))
#define SUB ((bf16_t*)(ws + WS_SU))
#define EB ((float*)(ws + WS_EB))
#define QT ((bf16_t*)(ws + WS_QT))
#define AM ((bf16_t*)(ws + WS_AM))
#define PRS ((float*)(ws + WS_PRS))
#define GLRP ((float*)(ws + WS_GLRP))
#define XSP ((float*)(ws + WS_XSP))
#define H ((bf16_t*)(ws + WS_H))
#define TAIL ((float*)(ws + WS_TAIL))
#define SSB ((float*)(ws + WS_SS))
#define SSP ((float*)(ws + WS_SSP))
#define HEAD ((float*)(ws + WS_HEAD))

    for (int rp_ = 0; rp_ < REP_P0; ++rp_) {
        PHASE_IDS
        LAS float* scr = (LAS float*)(lds + wid * 16384);
#if P0_WG
        { const P0Src ts{w_in, w_out, w_up, w_down, norm_mix_g, norm_ffn_g, WT_IN, WT_OUT, WT_UP, WT_DN}; LAS float* T = (LAS float*)lds;
          int it = bid; P0Desc dc, dn; f32x4 tv[8];
          bool have = p0_decode(it, ts, wid, lane, dc); if (have) p0_load(dc, tv);
          while (have) {
              p0_to_lds(dc, tv, T, wid, lane);
              __syncthreads();
              const bool hn = p0_decode(it + G, ts, wid, lane, dn); if (hn) p0_load(dn, tv);
              p0_out(dc, T, wid, lane);
              __syncthreads();
              have = hn; it += G; dc = dn;
          } }
#else
        constexpr int I_IN = 200 * 32, I_OUT = 64 * 32, I_UP = 352 * 32, I_DN = 64 * 88, I_L = I_IN + I_OUT + I_UP + I_DN;
        for (int it = gw; it < 2 * I_L; it += NGW) {
            const int l = it / I_L; int rr = it - l * I_L;
            if (rr < I_IN) { const int g = rr >> 5, kb = rr & 31; int src, nv; bool perm; win_map(g, src, nv, perm);
                tr_item(w_in + (size_t)l * DM * INC, INC, nv, DM, WT_IN + (size_t)l * INP * DM, g * 32, src, perm, kb, scr, lane, norm_mix_g + (size_t)l * DM); continue; }
            rr -= I_IN;
            if (rr < I_OUT) { const int g = rr >> 5, kb = rr & 31; tr_item(w_out + (size_t)l * DM * DM, DM, DM, DM, WT_OUT + (size_t)l * DM * DM, g * 32, g * 32, false, kb, scr, lane); continue; }
            rr -= I_OUT;
            if (rr < I_UP) { const int g = rr >> 5, kb = rr & 31; const int tile = g >> 3, gi = g & 7; const int src = (gi < 4) ? (128 * tile + 32 * gi) : (DFF + 128 * tile + 32 * (gi - 4));
                tr_item(w_up + (size_t)l * DM * UPN, UPN, UPN, DM, WT_UP + (size_t)l * UPN * DM, g * 32, src, true, kb, scr, lane, norm_ffn_g + (size_t)l * DM); continue; }
            rr -= I_UP;
            { const int g = rr / 88, kb = rr - g * 88; tr_item(w_down + (size_t)l * DFF * DM, DM, DM, DFF, WT_DN + (size_t)l * DM * DFF, g * 32, g * 32, false, kb, scr, lane); }
        }
#endif
        for (int m = gw; m < MPAD; m += NGW) {
            if (m < MREAL) row_bf16_ss(m < MP ? x_prompt + (size_t)m * DM : x_sample + (size_t)(m - MP) * DM, XN + (size_t)m * DM, SSB + m, lane);
            else { u32x4* o = (u32x4*)(XN + (size_t)m * DM) + lane; const u32x4 z = {0u, 0u, 0u, 0u};
#pragma unroll
                for (int j = 0; j < 4; ++j) o[64 * j] = z;
                if (lane == 0) SSB[m] = 0.f; }
        }
        for (int i = gt; i < 3 * MPAD; i += NGT) SSB[MPAD + i] = 0.f;
    }
    unsigned* barw_; { KP_DECL barw_ = (unsigned*)(ws + WS_BAR); }
    XcdBarrier xbar; xbar.bar = barw_; xbar.x = xb_xcc_id(); xbar.st = (volatile LAS unsigned*)(lds + LDS_BARST);
#define GRID_BAR() xcd_barrier(xbar)
    volatile LAS unsigned* vcw = (volatile LAS unsigned*)(lds + LDS_BARST + 16);
    GRID_BAR();
    if (threadIdx.x == 0) { bool even = (G == 256);
        for (unsigned j = 0; j < 8; ++j) even = even && (xb_ld(&barw_[XB_XCNT(j)]) == 32u);
        vcw[1] = even ? vcw[0] * 8u + xbar.x : (unsigned)bid; }
    __syncthreads();
    const int vcu = __builtin_amdgcn_readfirstlane((int)vcw[1]);

#pragma unroll 1
    for (int l = 0; l < 2; ++l) {
        for (int rp_ = 0; rp_ < REP_G1; ++rp_) { KP_DECL pg8::Gemm g{XN, WT_IN + (size_t)l * INP * DM, MPAD, INP, DM}; MixOrder<1> S; S.init(6144, 32, G, vcu);
          EpiIn E{PR, UC, GLRP, PRS, SSB + (size_t)(2 * l) * MPAD, out + O_CP + (size_t)l * NBATCH * 2 * CONVD};
          pg8::gemm_phase<EpiIn, MixOrder<1>, true, true>(lds, g, S, E); }
        GRID_BAR();
        for (int rp_ = 0; rp_ < REP_M1; ++rp_) {
            PHASE_IDS
            const float* w2 = gate_w2 + (size_t)l * RANK * QKD; const float* gb = gate_b + (size_t)l * QKD; const float* gn = gla_norm_g + (size_t)l * 1024;
            for (int ra_ = 0; ra_ < REP_M1A; ++ra_) for (int u = bid; u < 512; u += G) gla_passA(lds, u, PR, GLRP, w2, gb, SUB, EB, QT, AM, tid, wid, lane);
            for (int rs_ = 0; rs_ < REP_M1S; ++rs_) for (int u = bid; u < 512; u += G) gla_sample<true>(lds, u, PRS, GLRP, w2, gb, gn, state_gla + (size_t)l * NS * NH * DK * DV, out + O_GS + (size_t)l * NS * NH * DK * DV, Y, tid, wid, lane);
            const float* cw = conv_w + (size_t)l * 3 * CONVD;
            for (int rc_ = 0; rc_ < REP_M1C; ++rc_) for (int item = gt; item < (MP / 16) * 256; item += NGT) {
                const int c4 = (item & 255) * 4, row0 = (item >> 8) * 16; const bool cont = (row0 & (SEQ - 1)) != 0; const bf16_t* up = (const bf16_t*)UC + (size_t)row0 * CONVD + c4; const f32x4 z = {0.f, 0.f, 0.f, 0.f};
                f32x4 u[18]; u32x2 bg[16];
                u32x2 ub[18]; ub[0] = cont ? *(const u32x2*)(up - 2 * CONVD) : (u32x2){0u, 0u}; ub[1] = cont ? *(const u32x2*)(up - CONVD) : (u32x2){0u, 0u};
#pragma unroll
                for (int i = 0; i < 16; ++i) { ub[2 + i] = *(const u32x2*)(up + (size_t)i * CONVD); bg[i] = *(const u32x2*)(PR + (size_t)(row0 + i) * PRW + c4); }
                const f32x4 w0 = *(const f32x4*)(cw + c4), w1 = *(const f32x4*)(cw + CONVD + c4), w2v = *(const f32x4*)(cw + 2 * CONVD + c4);
#pragma unroll
                for (int i = 0; i < 18; ++i) u[i] = (f32x4){bf_lo(ub[i].x), bf_hi(ub[i].x), bf_lo(ub[i].y), bf_hi(ub[i].y)};
#pragma unroll
                for (int i = 0; i < 16; ++i) { const f32x4 bgf = {bf_lo(bg[i].x), bf_hi(bg[i].x), bf_lo(bg[i].y), bf_hi(bg[i].y)};
                    const f32x4 cu = (u[i] * w0 + u[i + 1] * w1 + u[i + 2] * w2v) * bgf;
                    u32x2 w; w.x = cvt_pk_bf16(cu.x, cu.y); w.y = cvt_pk_bf16(cu.z, cu.w);
                    *(u32x2*)(Y + (size_t)(row0 + i) * DM + c4) = w; }
            }
            for (int idx = gt; idx < NS * 256; idx += NGT) { const int s = idx >> 8, c4 = (idx & 255) * 4; const int row = MP + s;
                const f32x4 u0 = prs_sum4(PRS, s, 1024 + c4) * prs_sum4(PRS, s, 2048 + c4), bgf = prs_sum4(PRS, s, c4);
                const float* sp = state_conv + ((size_t)l * NS + s) * 2 * CONVD + c4; const f32x4 u2 = *(const f32x4*)sp, u1 = *(const f32x4*)(sp + CONVD);
                float* op = out + O_CS + ((size_t)l * NS + s) * 2 * CONVD + c4; *(f32x4*)op = u1; *(f32x4*)(op + CONVD) = u0;
                const f32x4 w0 = *(const f32x4*)(cw + c4), w1 = *(const f32x4*)(cw + CONVD + c4), w2v = *(const f32x4*)(cw + 2 * CONVD + c4);
                const f32x4 cu = (u2 * w0 + u1 * w1 + u0 * w2v) * bgf;
                u32x2 w; w.x = cvt_pk_bf16(cu.x, cu.y); w.y = cvt_pk_bf16(cu.z, cu.w);
                *(u32x2*)(Y + (size_t)row * DM + c4) = w; }
        }
        GRID_BAR();
        { PHASE_IDS
        for (int e = gt; e < 16 * DK * 64; e += NGT) { const int bh = e >> 13, rem = e & 8191, k = rem >> 6, dq = rem & 63;
            bf16_t* sp = SUB + (size_t)bh * NCH * (DK * DV) + k * DV + 4 * dq; const float* ep = EB + (size_t)bh * NCH * DK + k; f32x4 S = {0.f, 0.f, 0.f, 0.f};
#pragma unroll 1
            for (int c0 = 0; c0 < NCH; c0 += 16) { u32x2 uu[16]; float ee[16];
#pragma unroll
                for (int i = 0; i < 16; ++i) { uu[i] = *(const u32x2*)(sp + (size_t)(c0 + i) * (DK * DV)); ee[i] = ep[(c0 + i) * DK]; }
#pragma unroll
                for (int i = 0; i < 16; ++i) { u32x2 w; w.x = cvt_pk_bf16(S.x, S.y); w.y = cvt_pk_bf16(S.z, S.w); *(u32x2*)(sp + (size_t)(c0 + i) * (DK * DV)) = w;
                    S = S * ee[i] + (f32x4){bf_lo(uu[i].x), bf_hi(uu[i].x), bf_lo(uu[i].y), bf_hi(uu[i].y)}; } }
            *(f32x4*)(out + O_GP + ((size_t)l * 16 + bh) * (DK * DV) + k * DV + 4 * dq) = S; } }
        GRID_BAR();
        for (int rp_ = 0; rp_ < REP_M3; ++rp_) { PHASE_IDS const float* gn = gla_norm_g + (size_t)l * 1024; for (int u = bid; u < 512; u += G) gla_passC(lds, u, PR, SUB, QT, AM, gn, Y, tid, wid, lane); }
        GRID_BAR();
        { KP_DECL pg8::Gemm g{Y, WT_OUT + (size_t)l * DM * DM, MPAD, DM, DM}; MixOrder<2> S; S.init(DM, 32, G, vcu);
          EpiRes E{l == 0 ? x_prompt : nullptr, nullptr, XSP, XN, SSP};
          pg8::gemm_phase<EpiRes, MixOrder<2>, true, true>(lds, g, S, E); }
        GRID_BAR();
        for (int rp_ = 0; rp_ < REP_NRM; ++rp_) { PHASE_IDS
              for (int r = gt; r < MP; r += NGT) { const f32x4* sp = (const f32x4*)(SSP + (size_t)r * 32); f32x4 t = sp[0];
#pragma unroll
                  for (int j = 1; j < 8; ++j) t += sp[j];
                  SSB[(size_t)(2 * l + 1) * MPAD + r] = (t.x + t.y) + (t.z + t.w); }
              for (int m = MP + gw; m < MREAL; m += NGW) {
                  if (rp_ == 0) sample_assemble(l == 0 ? x_sample + (size_t)(m - MP) * DM : XR + (size_t)m * DM, XSP, 8, m - MP, XR + (size_t)m * DM, lane);
                  row_bf16_ss(XR + (size_t)m * DM, XN + (size_t)m * DM, SSB + (size_t)(2 * l + 1) * MPAD + m, lane); } }
        GRID_BAR();
        for (int rp_ = 0; rp_ < REP_UP; ++rp_) { KP_DECL pg8::Gemm g{XN, WT_UP + (size_t)l * UPN * DM, MPAD, UPN, DM}; MixOrder<3> S; S.init(UPN, 32, G, vcu);
          EpiUp E{H, ffn_conv_w + (size_t)l * 3 * DFF, ffn_conv_b + (size_t)l * DFF, TAIL, HEAD, state_ffn + (size_t)l * NS * 2 * DFF, out + O_FP + (size_t)l * NBATCH * 2 * DFF, out + O_FS + (size_t)l * NS * 2 * DFF, (LAS float*)(lds + LDS_HALO), SSB + (size_t)(2 * l + 1) * MPAD};
          pg8::gemm_phase<EpiUp, MixOrder<3>, true, true>(lds, g, S, E); }
        {
            PHASE_IDS const int first = (G == 256) ? 172 : 0, nw = G - first;
            const float* w2 = gate_w2 + (size_t)l * RANK * QKD; const float* gb = gate_b + (size_t)l * QKD;
            if (DEFER_STATE && bid >= first) for (int u = bid - first; u < 512; u += nw) gla_sample<false>(lds, u, PRS, GLRP, w2, gb, nullptr, state_gla + (size_t)l * NS * NH * DK * DV, out + O_GS + (size_t)l * NS * NH * DK * DV, nullptr, tid, wid, lane);
        }
        GRID_BAR();
        { PHASE_IDS MixOrder<4> S0; S0.init(DM, 88, G, vcu); pg8::Unit u0;
          for (int ui = 0; S0.next(ui, u0); ++ui) if (u0.sp < 0 && (u0.pm & 7) != 0) { const int pm = u0.pm; const float* cw = ffn_conv_w + (size_t)l * 3 * DFF; const float* cb = ffn_conv_b + (size_t)l * DFF;
            for (int idx = tid; idx < 2 * (DFF / 4); idx += NTHR) { const int j = idx / (DFF / 4), c4 = (idx - j * (DFF / 4)) * 4;
              const f32x4 t0 = *(const f32x4*)(TAIL + ((size_t)(pm - 1) * 2 + 0) * DFF + c4), t1 = *(const f32x4*)(TAIL + ((size_t)(pm - 1) * 2 + 1) * DFF + c4);
              const f32x4 hu0 = *(const f32x4*)(HEAD + ((size_t)pm * 2 + 0) * 2 * DFF + c4), hu1 = *(const f32x4*)(HEAD + ((size_t)pm * 2 + 1) * 2 * DFF + c4), hv = *(const f32x4*)(HEAD + ((size_t)pm * 2 + j) * 2 * DFF + DFF + c4);
              const f32x4 w0 = *(const f32x4*)(cw + c4), w1 = *(const f32x4*)(cw + DFF + c4), w2v = *(const f32x4*)(cw + 2 * DFF + c4), bv = *(const f32x4*)(cb + c4);
              const f32x4 cu = j == 0 ? (t0 * w0 + t1 * w1 + hu0 * w2v + bv) : (t1 * w0 + hu0 * w1 + hu1 * w2v + bv);
              u32x2 w; w.x = cvt_pk_bf16(silu_f(cu.x) * hv.x, silu_f(cu.y) * hv.y); w.y = cvt_pk_bf16(silu_f(cu.z) * hv.z, silu_f(cu.w) * hv.w);
              *(u32x2*)(H + (size_t)(pm * 256 + j) * DFF + c4) = w; }
            asm volatile("s_waitcnt vmcnt(0)" ::: "memory"); }
          __syncthreads(); }
        { KP_DECL pg8::Gemm g{H, WT_DN + (size_t)l * DM * DFF, MPAD, DM, DFF}; MixOrder<4> S; S.init(DM, 88, G, vcu);
          EpiRes E{nullptr, nullptr, XSP, XN, l == 0 ? SSP : nullptr};
          pg8::gemm_phase<EpiRes, MixOrder<4>, true, true>(lds, g, S, E); }
        GRID_BAR();
        if (l == 0) { PHASE_IDS
              for (int r = gt; r < MP; r += NGT) { const f32x4* sp = (const f32x4*)(SSP + (size_t)r * 32); f32x4 t = sp[0];
#pragma unroll
                  for (int j = 1; j < 8; ++j) t += sp[j];
                  SSB[(size_t)2 * MPAD + r] = (t.x + t.y) + (t.z + t.w); }
              for (int m = MP + gw; m < MREAL; m += NGW) { sample_assemble(XR + (size_t)m * DM, XSP, 11, m - MP, XR + (size_t)m * DM, lane);
                  row_bf16_ss(XR + (size_t)m * DM, XN + (size_t)m * DM, SSB + (size_t)2 * MPAD + m, lane); }
            GRID_BAR(); }
    }
    PHASE_IDS
    if (bid == 0 && tid == 0) __hip_atomic_store((unsigned*)(ws + WS_BAR) + 4000, 0u, __ATOMIC_RELAXED, __HIP_MEMORY_SCOPE_AGENT);
    for (int m = gw; m < MREAL; m += NGW) {
        if (m >= MP) { sample_assemble(XR + (size_t)m * DM, XSP, 11, m - MP, XR + (size_t)m * DM, lane); rms_row_f32(XR + (size_t)m * DM, final_norm_g, out + O_YS + (size_t)(m - MP) * DM, lane); }
        else { const u32x2* xr = (const u32x2*)(XN + (size_t)m * DM) + lane; f32x4 v[8]; float sq = 0.f;
#pragma unroll
            for (int j = 0; j < 8; ++j) { const u32x2 w = xr[64 * j]; v[j] = (f32x4){bf_lo(w.x), bf_hi(w.x), bf_lo(w.y), bf_hi(w.y)}; sq += (v[j].x * v[j].x + v[j].y * v[j].y) + (v[j].z * v[j].z + v[j].w * v[j].w); }
            const float rstd = rsqrtf(wave_sum(sq) * (1.f / DM) + EPS); const f32x4* gr = (const f32x4*)final_norm_g + lane; f32x4* o = (f32x4*)(out + O_YP + (size_t)m * DM) + lane;
#pragma unroll
            for (int j = 0; j < 8; ++j) o[64 * j] = v[j] * rstd * gr[64 * j]; } }
}

#undef x_prompt
#undef x_sample
#undef state_conv
#undef state_gla
#undef state_ffn
#undef norm_mix_g
#undef w_in
#undef conv_w
#undef gate_w2
#undef gate_b
#undef gla_norm_g
#undef w_out
#undef norm_ffn_g
#undef w_up
#undef ffn_conv_w
#undef ffn_conv_b
#undef w_down
#undef final_norm_g
#undef out
#undef ws
#undef WT_IN
#undef WT_OUT
#undef WT_UP
#undef WT_DN
#undef XN
#undef XR
#undef PR
#undef UC
#undef Y
#undef SUB
#undef EB
#undef QT
#undef AM
#undef PRS
#undef GLRP
#undef XSP
#undef H
#undef TAIL
#undef SSB
#undef SSP
#undef HEAD
extern "C" void kernel_launch(void* const* d_in, const int* in_sizes, int n_in, void* d_out, int out_size, void* d_ws, size_t ws_size, hipStream_t stream) {
    static int grid = 0;
    if (grid == 0) {
        if (n_in != 18 || (size_t)out_size != O_TOTAL || ws_size < WS_TOTAL) { fprintf(stderr, "kernel_launch: unexpected shapes: n_in %d out %d ws %zu (need %zu)\n", n_in, out_size, ws_size, (size_t)WS_TOTAL); grid = -1; return; }
        int dev = 0, cus = 0, per_cu = 0;
        hipGetDevice(&dev); hipDeviceGetAttribute(&cus, hipDeviceAttributeMultiprocessorCount, dev);
        if (hipFuncSetAttribute((const void*)fwd_kernel, hipFuncAttributeMaxDynamicSharedMemorySize, LDS_BYTES) != hipSuccess) { fprintf(stderr, "kernel_launch: hipFuncSetAttribute failed\n"); grid = -1; return; }
        if (hipOccupancyMaxActiveBlocksPerMultiprocessor(&per_cu, (const void*)fwd_kernel, NTHR, LDS_BYTES) != hipSuccess || per_cu < 1) { fprintf(stderr, "kernel_launch: occupancy query says %d\n", per_cu); per_cu = 1; }
        (void)hipGetLastError();
        grid = cus;
    }
    if (grid < 0) return;
    Args a{};
    for (int i = 0; i < 18; ++i) a.in[i] = (const float*)d_in[i];
    a.out = (float*)d_out; a.ws = (unsigned char*)d_ws;
    void* args[] = {&a};
    hipError_t e = hipLaunchCooperativeKernel((const void*)fwd_kernel, dim3(grid), dim3(NTHR), args, LDS_BYTES, stream);
    if (e != hipSuccess) fprintf(stderr, "kernel_launch: cooperative launch failed: %s (grid %d)\n", hipGetErrorString(e), grid);
}
```

```cpp
#define TR_GATHER 1
#include <hip/hip_runtime.h>
#include <hip/hip_cooperative_groups.h>
#include <cstdio>
#include <cstdint>
namespace cg = cooperative_groups;
namespace pg8 {
#define PG8_LAS __attribute__((address_space(3)))
typedef unsigned short bf16_t;
typedef short bf16x8 __attribute__((ext_vector_type(8)));
typedef float f32x4 __attribute__((ext_vector_type(4)));
typedef unsigned u32x4 __attribute__((ext_vector_type(4)));
constexpr int BM = 256, BK = 64, HALF = 128, HTB = HALF * BK * 2  , STAGE_BYTES = 8 * HTB, NXCD = 8, WGM = 8;

__host__ __device__ __forceinline__ int lds_byte(int r, int c) { const int st = (r >> 4) * 2 + (c >> 5), rr = r & 15, cc = c & 31, ob = rr * 64 + cc * 2; return st * 1024 + (ob ^ (((ob >> 9) & 1) << 5)); }
__host__ __device__ __forceinline__ void stage_rc(int b, int& R, int& C) { const int st = b / 1024, sb = b % 1024, swz = sb ^ (((sb >> 9) & 1) << 5); R = (st >> 1) * 16 + swz / 64; C = (st & 1) * 32 + (swz % 64) / 2; }
__host__ __device__ __forceinline__ int perm32(int rho) { const int n = rho >> 4, i = rho & 15; return 8 * (i >> 2) + 4 * n + (i & 3); }

struct Unit { int pm, pn, k0, nt, sp; };
struct Gemm { const bf16_t* A; const bf16_t* Bt; int M, N, K; };

struct StaticOrder {
    int nM, nN, nwg, G, c;
    __host__ __device__ void init(int M, int N, int G_, int c_) { nM = M / BM; nN = N / BM; nwg = nM * nN; G = G_; c = c_; }
    __host__ __device__ bool next(int i, Unit& u) const {
        const long L = (long)i * G + c; if (L >= nwg) return false;
        int wgid = (int)L; { const int q = nwg / NXCD, r = nwg % NXCD, xcd = wgid % NXCD, off = wgid / NXCD; wgid = (xcd < r ? xcd * (q + 1) : r * (q + 1) + (xcd - r) * q) + off; }
        const int nig = WGM * nN, gid = wgid / nig, fm = gid * WGM, gsz = (nM - fm) < WGM ? (nM - fm) : WGM;
        u.pm = fm + ((wgid % nig) % gsz); u.pn = (wgid % nig) / gsz; u.k0 = 0; u.sp = -1; return true;
    }
    __device__ __forceinline__ void a_ready(const Unit&) const {}
    __device__ __forceinline__ void done(const Unit&) const {}
};
__device__ __forceinline__ unsigned cvt_pk_bf16(float lo, float hi) { unsigned r; asm volatile("v_cvt_pk_bf16_f32 %0, %1, %2" : "=v"(r) : "v"(lo), "v"(hi)); return r; }
typedef float f32x2 __attribute__((ext_vector_type(2)));
template <class Epi, class Sched, bool ALIGN_EPI = false, bool SP2 = false>
__device__ __forceinline__ void gemm_phase(PG8_LAS unsigned char* lds, const Gemm g, const Sched& S, const Epi& E) {
    int tid = threadIdx.x; asm volatile("" : "+v"(tid)); const int wid = __builtin_amdgcn_readfirstlane(tid >> 6), lane = tid & 63, wr = wid >> 2, wc = wid & 3, fr = lane & 15, fq = lane >> 4;
    const int K = g.K;
    unsigned voffA[2], voffB[2];
#pragma unroll
    for (int i = 0; i < 2; ++i) { int R, C; stage_rc(tid * 16 + i * 8192, R, C); const int Rb = Epi::PERM ? ((R & ~31) + perm32(R & 31)) : R;
        voffA[i] = (unsigned)(R * K + C) * 2u; voffB[i] = (unsigned)(Rb * K + C) * 2u; }
    const size_t kstep = (size_t)(BK * 2);
    const size_t hstep = (size_t)HALF * K * 2;
    const size_t tstep = 2 * hstep;
    const unsigned ldsw = (unsigned)wid * 1024u;
    const int aoff = lds_byte(wr * 64 + fr, fq * 8), boff = lds_byte(wc * 32 + fr, fq * 8);
#define PG8_SA(b, h) (((b) * 2 + (h)) * HTB)
#define PG8_SB(b, h) ((4 + (b) * 2 + (h)) * HTB)
#define PG8_STAGE(bufoff, gbase, voff) do { _Pragma("unroll") for (int _i = 0; _i < 2; ++_i) \
        __builtin_amdgcn_global_load_lds((const unsigned*)((const char*)(gbase) + (voff)[_i]), (PG8_LAS unsigned*)(lds + (bufoff) + ldsw + _i * 8192), 16, 0, 0); } while (0)
#define PG8_LDA(dst, b, h) do { _Pragma("unroll") for (int m = 0; m < 4; ++m) _Pragma("unroll") for (int k = 0; k < 2; ++k) dst[m][k] = *(const PG8_LAS bf16x8*)(lds + PG8_SA(b, h) + aoff + m * 2048 + k * 1024); } while (0)
#define PG8_LDB(dst, b, h) do { _Pragma("unroll") for (int n = 0; n < 2; ++n) _Pragma("unroll") for (int k = 0; k < 2; ++k) dst[n][k] = *(const PG8_LAS bf16x8*)(lds + PG8_SB(b, h) + boff + n * 2048 + k * 1024); } while (0)
#define PG8_MMA(ai, bj, At, Bt) do { __builtin_amdgcn_s_setprio(1); _Pragma("unroll") for (int m = 0; m < 4; ++m) _Pragma("unroll") for (int n = 0; n < 2; ++n) _Pragma("unroll") for (int k = 0; k < 2; ++k) \
        acc[ai][bj][m][n] = __builtin_amdgcn_mfma_f32_16x16x32_bf16(Bt[n][k], At[m][k], acc[ai][bj][m][n], 0, 0, 0); __builtin_amdgcn_s_setprio(0); } while (0)
#define PG8_WAIT_V(n) asm volatile("s_waitcnt vmcnt(" #n ")" ::: "memory")
#define PG8_WAIT_L(n) asm volatile("s_waitcnt lgkmcnt(" #n ")" ::: "memory")
#define PG8_BAR __builtin_amdgcn_s_barrier()
#define PG8_SCHED __builtin_amdgcn_sched_barrier(0)
    Unit cur, nxt; int ui = 0;
    if (!S.next(0, cur)) return;
    f32x4 acc[2][2][4][2];
#pragma unroll
    for (int a = 0; a < 2; ++a)
#pragma unroll
        for (int b = 0; b < 2; ++b)
#pragma unroll
            for (int m = 0; m < 4; ++m)
#pragma unroll
                for (int n = 0; n < 2; ++n) acc[a][b][m][n] = (f32x4){0.f, 0.f, 0.f, 0.f};
    bf16x8 At[4][2], B0[2][2], B1[2][2];
    const char* cA = (const char*)g.A + (size_t)cur.pm * tstep + (size_t)cur.k0 * kstep; const char* cB = (const char*)g.Bt + (size_t)cur.pn * tstep + (size_t)cur.k0 * kstep;
    S.a_ready(cur);
    if constexpr (SP2) {
        PG8_STAGE(PG8_SB(0, 0), cB, voffB); PG8_STAGE(PG8_SB(0, 1), cB + hstep, voffB); PG8_STAGE(PG8_SA(0, 0), cA, voffA); PG8_STAGE(PG8_SA(0, 1), cA + hstep, voffA);
        if (wr == 1) PG8_BAR;
        PG8_WAIT_V(2); PG8_BAR;
        PG8_STAGE(PG8_SB(1, 0), cB + kstep, voffB); PG8_STAGE(PG8_SA(1, 0), cA + kstep, voffA); PG8_STAGE(PG8_SB(1, 1), cB + hstep + kstep, voffB);
        PG8_WAIT_V(6); PG8_BAR;
    } else {
        PG8_STAGE(PG8_SB(0, 0), cB, voffB); PG8_STAGE(PG8_SA(0, 0), cA, voffA); PG8_STAGE(PG8_SB(0, 1), cB + hstep, voffB); PG8_STAGE(PG8_SA(0, 1), cA + hstep, voffA);
        if (wr == 1) PG8_BAR;
        PG8_WAIT_V(4); PG8_BAR;
        PG8_STAGE(PG8_SB(1, 0), cB + kstep, voffB); PG8_STAGE(PG8_SA(1, 0), cA + kstep, voffA); PG8_STAGE(PG8_SB(1, 1), cB + hstep + kstep, voffB);
        PG8_WAIT_V(6); PG8_BAR;
    }
    for (;;) {
        const bool has_next = S.next(ui + 1, nxt);
        const char* nA = has_next ? (const char*)g.A + (size_t)nxt.pm * tstep + (size_t)nxt.k0 * kstep : cA; const char* nB = has_next ? (const char*)g.Bt + (size_t)nxt.pn * tstep + (size_t)nxt.k0 * kstep : cB;
        const int nt = cur.nt;
        for (int t = 0; t < nt; t += 2) {
            const bool last = (t == nt - 2);
            const char* a1 = cA + (size_t)(t + 1) * kstep;
            const char* a2 = last ? nA : cA + (size_t)(t + 2) * kstep; const char* b2 = last ? nB : cB + (size_t)(t + 2) * kstep;
            const char* a3 = a2 + kstep; const char* b3 = b2 + kstep;
            if (last && has_next) S.a_ready(nxt);
            if constexpr (SP2) {
            PG8_LDB(B0, 0, 0); PG8_LDB(B1, 0, 1); PG8_SCHED; PG8_LDA(At, 0, 0); PG8_STAGE(PG8_SA(1, 1), a1 + hstep, voffA);
            PG8_WAIT_V(8); PG8_WAIT_L(0); PG8_BAR; PG8_MMA(0, 0, At, B0); PG8_MMA(0, 1, At, B1); PG8_BAR; PG8_SCHED;
            PG8_LDA(At, 0, 1); PG8_STAGE(PG8_SB(0, 0), b2, voffB); PG8_STAGE(PG8_SB(0, 1), b2 + hstep, voffB); PG8_STAGE(PG8_SA(0, 0), a2, voffA);
            PG8_WAIT_V(8); PG8_WAIT_L(0); PG8_BAR; PG8_MMA(1, 0, At, B0); PG8_MMA(1, 1, At, B1); PG8_BAR; PG8_SCHED;
            PG8_LDB(B0, 1, 0); PG8_LDB(B1, 1, 1); PG8_SCHED; PG8_LDA(At, 1, 0); PG8_STAGE(PG8_SA(0, 1), a2 + hstep, voffA);
            PG8_WAIT_V(8); PG8_WAIT_L(0); PG8_BAR; PG8_MMA(0, 0, At, B0); PG8_MMA(0, 1, At, B1); PG8_BAR; PG8_SCHED;
            PG8_LDA(At, 1, 1); PG8_STAGE(PG8_SB(1, 0), b3, voffB); PG8_STAGE(PG8_SB(1, 1), b3 + hstep, voffB); PG8_STAGE(PG8_SA(1, 0), a3, voffA);
            PG8_WAIT_V(8); PG8_WAIT_L(0); PG8_BAR; PG8_MMA(1, 0, At, B0); PG8_MMA(1, 1, At, B1); PG8_BAR; PG8_SCHED;
            } else {
            PG8_LDB(B0, 0, 0); PG8_SCHED; PG8_LDA(At, 0, 0); PG8_STAGE(PG8_SA(1, 1), a1 + hstep, voffA);
            PG8_WAIT_L(8); PG8_BAR; PG8_WAIT_L(0); PG8_MMA(0, 0, At, B0); PG8_BAR; PG8_SCHED;
            PG8_LDB(B1, 0, 1); PG8_STAGE(PG8_SB(0, 0), b2, voffB);
            PG8_BAR; PG8_WAIT_L(0); PG8_MMA(0, 1, At, B1); PG8_BAR;
            PG8_LDA(At, 0, 1); PG8_STAGE(PG8_SA(0, 0), a2, voffA);
            PG8_BAR; PG8_WAIT_L(0); PG8_MMA(1, 0, At, B0); PG8_BAR; PG8_SCHED;
            PG8_STAGE(PG8_SB(0, 1), b2 + hstep, voffB);
            PG8_WAIT_V(6); PG8_BAR; PG8_MMA(1, 1, At, B1); PG8_BAR;
            PG8_LDB(B0, 1, 0); PG8_SCHED; PG8_LDA(At, 1, 0); PG8_STAGE(PG8_SA(0, 1), a2 + hstep, voffA);
            PG8_WAIT_L(8); PG8_BAR; PG8_WAIT_L(0); PG8_MMA(0, 0, At, B0); PG8_BAR; PG8_SCHED;
            PG8_LDB(B1, 1, 1); PG8_STAGE(PG8_SB(1, 0), b3, voffB);
            PG8_BAR; PG8_WAIT_L(0); PG8_MMA(0, 1, At, B1); PG8_BAR;
            PG8_LDA(At, 1, 1); PG8_STAGE(PG8_SA(1, 0), a3, voffA);
            PG8_BAR; PG8_WAIT_L(0); PG8_MMA(1, 0, At, B0); PG8_BAR; PG8_SCHED;
            PG8_STAGE(PG8_SB(1, 1), b3 + hstep, voffB);
            PG8_WAIT_V(6); PG8_BAR; PG8_MMA(1, 1, At, B1); PG8_BAR;
            }
        }
        if constexpr (ALIGN_EPI) { if (wr == 0) PG8_BAR; }
        if constexpr (!Epi::AFTER_DRAIN) { E(acc, cur, wr, wc, fr, fq); S.done(cur); }
        if (!has_next) break;
#pragma unroll
        for (int a = 0; a < 2; ++a)
#pragma unroll
            for (int b = 0; b < 2; ++b)
#pragma unroll
                for (int m = 0; m < 4; ++m)
#pragma unroll
                    for (int n = 0; n < 2; ++n) acc[a][b][m][n] = (f32x4){0.f, 0.f, 0.f, 0.f};
        cur = nxt; cA = nA; cB = nB; ++ui;
        if constexpr (ALIGN_EPI) { if (wr == 1) PG8_BAR; }
    }
    PG8_WAIT_V(0);
    if constexpr (!ALIGN_EPI) { if (wr == 0) PG8_BAR; }
    PG8_BAR;
    if constexpr (Epi::AFTER_DRAIN) { E.fused(acc, cur, wr, wc, fr, fq, lds, wid, lane); S.done(cur); }
#undef PG8_SA
#undef PG8_SB
#undef PG8_STAGE
#undef PG8_LDA
#undef PG8_LDB
#undef PG8_MMA
#undef PG8_WAIT_V
#undef PG8_WAIT_L
#undef PG8_BAR
#undef PG8_SCHED
}
}

#ifndef REP_P0
#define REP_P0 1
#endif
#ifndef REP_G1
#define REP_G1 1
#endif
#ifndef REP_M1
#define REP_M1 1
#endif
#ifndef REP_M3
#define REP_M3 1
#endif
#ifndef REP_UP
#define REP_UP 1
#endif
#ifndef REP_ACT
#define REP_ACT 1
#endif
#ifndef REP_NRM
#define REP_NRM 1
#endif
#ifndef DEFER_STATE
#define DEFER_STATE 0
#endif
#ifndef REP_M1A
#define REP_M1A 1
#endif
#ifndef REP_M1S
#define REP_M1S 1
#endif
#ifndef REP_M1C
#define REP_M1C 1
#endif
#ifndef NT_EPI
#define NT_EPI 0
#endif
#if NT_EPI
#define EPI_ST(p, v) __builtin_nontemporal_store((v), (p))
#else
#define EPI_ST(p, v) (*(p) = (v))
#endif
#ifndef RUN_FIX
#define RUN_FIX 0
#endif
#ifndef P0_WG
#define P0_WG 1
#endif
using pg8::bf16_t; using pg8::bf16x8; using pg8::f32x4; using pg8::u32x4; using pg8::cvt_pk_bf16;
typedef unsigned u32x2 __attribute__((ext_vector_type(2)));
#define LAS __attribute__((address_space(3)))
constexpr int DM = 2048, SEQ = 2048, NBATCH = 4, MP = 8192, NS = 128, MREAL = 8320, MPAD = 8448;
constexpr int CONVD = 1024, NH = 4, DK = 128, DV = 256, QKD = 512, RANK = 16, DFF = 5632;
constexpr int INC = 6160, INP = 6400, UPN = 11264, PRW = 4096;
constexpr int NCH = 32, NTHR = 512;
constexpr float EPS = 1e-6f;
constexpr size_t O_YP = 0, O_YS = 16777216, O_CP = 17039360, O_GP = 17055744, O_FP = 18104320, O_CS = 18194432, O_GS = 18718720, O_FS = 52273152, O_TOTAL = 55156736;
constexpr size_t SZ_WIN = (size_t)INP * DM * 2, SZ_WOUT = (size_t)DM * DM * 2, SZ_WUP = (size_t)UPN * DM * 2, SZ_WDN = (size_t)DM * DFF * 2;
constexpr size_t WS_WIN = 0, WS_WOUT = WS_WIN + 2 * SZ_WIN, WS_WUP = WS_WOUT + 2 * SZ_WOUT, WS_WDN = WS_WUP + 2 * SZ_WUP;
constexpr size_t WS_XN = WS_WDN + 2 * SZ_WDN, WS_XR = WS_XN + (size_t)MPAD * DM * 2, WS_R = WS_XR + (size_t)MPAD * DM * 4;
constexpr size_t WS_PR = WS_R, WS_UC = WS_PR + (size_t)MPAD * PRW * 2, WS_GLR = WS_UC + (size_t)MPAD * CONVD * 4, WS_Y = WS_GLR + (size_t)MPAD * RANK * 4;
constexpr size_t WS_SU = WS_Y + (size_t)MPAD * DM * 2, WS_EB = WS_SU + (size_t)16 * NCH * DK * DV * 4, WS_QT = WS_EB + (size_t)16 * NCH * DK * 4, WS_AM = WS_QT + (size_t)MP * QKD * 2;
constexpr size_t WS_MIX_END = WS_AM + (size_t)512 * 4096 * 2;
constexpr size_t WS_H = WS_R, WS_FFN_END = WS_H + (size_t)MPAD * DFF * 2;
constexpr size_t WS_REND = WS_FFN_END > WS_MIX_END ? WS_FFN_END : WS_MIX_END;
constexpr int PRSW = 6400, NSP1 = 4;
constexpr size_t WS_PRS = WS_REND, WS_GLRP = WS_PRS + (size_t)8 * NS * PRSW * 4, WS_XSP = WS_GLRP + (size_t)8 * MPAD * RANK * 4, WS_END = WS_XSP + (size_t)11 * NS * DM * 4;
constexpr size_t WS_BAR = WS_END;
constexpr size_t WS_SS = WS_BAR + 16384, WS_SSP = WS_SS + (size_t)4 * MPAD * 4, WS_TAIL = WS_SSP + (size_t)MP * 32 * 4, WS_HEAD = WS_TAIL + (size_t)132 * 2 * DFF * 4, WS_TOTAL = WS_HEAD + (size_t)132 * 4 * DFF * 4;
constexpr int LDS_BYTES = 147456, LDS_BARST = LDS_BYTES - 64, LDS_HALO = 131072 + 2048;

__device__ __forceinline__ float bf_lo(unsigned w) { return __uint_as_float(w << 16); }
__device__ __forceinline__ float bf_hi(unsigned w) { return __uint_as_float(w & 0xffff0000u); }
__device__ __forceinline__ float bf1(bf16_t h) { return __uint_as_float((unsigned)h << 16); }
__device__ __forceinline__ bf16_t f2bf(float f) { return (bf16_t)(cvt_pk_bf16(f, 0.f) & 0xffffu); }
__device__ __forceinline__ float silu_f(float x) { return x * __builtin_amdgcn_rcpf(1.f + __expf(-x)); }
__device__ __forceinline__ float logsig_f(float z) { return fminf(z, 0.f) - __logf(1.f + __expf(-fabsf(z))); }
__device__ __forceinline__ float wave_sum(float v) {
#pragma unroll
    for (int o = 1; o < 64; o <<= 1) v += __shfl_xor(v, o);
    return v;
}
#define LDS_WAIT() asm volatile("s_waitcnt lgkmcnt(0)" ::: "memory")

__device__ __forceinline__ void tr_item(const float* W, int ldw, int ncols_valid, int K, bf16_t* WT, int dst_row0, int src_col0, bool perm, int kb, LAS float* scr, int lane, const float* gk = nullptr) {
    const int k0 = 64 * kb; const int c = src_col0 + (lane & 31); const bool ok = c < ncols_valid;
    float tv[32];
#pragma unroll
    for (int i = 0; i < 32; ++i) { const int kk = 2 * i + (lane >> 5); tv[i] = ok ? W[(size_t)(k0 + kk) * ldw + c] : 0.f; }
#pragma unroll
    for (int i = 0; i < 32; ++i) { const int kk = 2 * i + (lane >> 5); scr[kk * 33 + (lane & 31)] = gk ? tv[i] * gk[k0 + kk] : tv[i]; }
    LDS_WAIT(); asm volatile("" ::: "memory");
    const int c8 = lane & 7;
#pragma unroll
    for (int j = 0; j < 4; ++j) { const int n = (lane >> 3) + 8 * j; const int sc = perm ? pg8::perm32(n) : n; const LAS float* s = scr + (8 * c8) * 33 + sc;
        u32x4 o; o.x = cvt_pk_bf16(s[0 * 33], s[1 * 33]); o.y = cvt_pk_bf16(s[2 * 33], s[3 * 33]); o.z = cvt_pk_bf16(s[4 * 33], s[5 * 33]); o.w = cvt_pk_bf16(s[6 * 33], s[7 * 33]);
        *(u32x4*)(WT + (size_t)(dst_row0 + n) * K + k0 + 8 * c8) = o; }
    LDS_WAIT(); asm volatile("" ::: "memory");
}
__device__ __forceinline__ void win_map(int g, int& src, int& nvalid, bool& perm) {
    const int tile = g >> 3, gi = g & 7; nvalid = INC;
    if (tile < 8) { perm = false; src = (gi < 4) ? (1024 + 128 * tile + 32 * gi) : (2048 + 128 * tile + 32 * (gi - 4)); }
    else if (tile < 12) { perm = true; src = 256 * (tile - 8) + 32 * gi; }
    else if (tile < 24) { perm = true; src = 3072 + 256 * (tile - 12) + 32 * gi; }
    else { perm = false; src = 6144; if (gi != 0) nvalid = 0; }
}
struct P0Desc { const float* src; size_t ldw; const float* gk; bf16_t* dst; int K; bool ok, perm; };
constexpr int P0_I_IN = 25 * 32, P0_I_OUT = 8 * 32, P0_I_UP = 44 * 32, P0_I_DN = 8 * 88, P0_I_L = P0_I_IN + P0_I_OUT + P0_I_UP + P0_I_DN;
struct P0Src { const float *w_in, *w_out, *w_up, *w_down, *g_mix, *g_ffn; bf16_t *WT_IN, *WT_OUT, *WT_UP, *WT_DN; };
__device__ __forceinline__ bool p0_decode(int it, const P0Src& t, int wid, int lane, P0Desc& d) {
    if (it >= 2 * P0_I_L) return false;
    const int l = it / P0_I_L; int rr = it - l * P0_I_L; const float* W; int ldw, nv, K, blk, kb, dg; bf16_t* WT; bool perm; const float* gk = nullptr;
    if (rr < P0_I_IN) { blk = rr >> 5; kb = rr & 31; const int sg = blk * 8 + wid; W = t.w_in + (size_t)l * DM * INC; ldw = INC; nv = INC; K = DM; WT = t.WT_IN + (size_t)l * INP * DM; gk = t.g_mix + (size_t)l * DM;
        if (sg < 32) { dg = 64 + sg; perm = true; } else if (sg < 64) { const int q = sg - 32; dg = (q >> 2) * 8 + (q & 3); perm = true; } else if (sg < 96) { const int q = sg - 64; dg = (q >> 2) * 8 + 4 + (q & 3); perm = true; }
        else { dg = sg; perm = sg < 192; } }
    else if ((rr -= P0_I_IN) < P0_I_OUT) { blk = rr >> 5; kb = rr & 31; dg = blk * 8 + wid; perm = true; W = t.w_out + (size_t)l * DM * DM; ldw = DM; nv = DM; K = DM; WT = t.WT_OUT + (size_t)l * DM * DM; }
    else if ((rr -= P0_I_OUT) < P0_I_UP) { blk = rr >> 5; kb = rr & 31; const int sg = blk * 8 + wid; perm = true; W = t.w_up + (size_t)l * DM * UPN; ldw = UPN; nv = UPN; K = DM; WT = t.WT_UP + (size_t)l * UPN * DM; gk = t.g_ffn + (size_t)l * DM;
        if (sg < 176) dg = (sg >> 2) * 8 + (sg & 3); else { const int q = sg - 176; dg = (q >> 2) * 8 + 4 + (q & 3); } }
    else { rr -= P0_I_UP; blk = rr / 88; kb = rr - blk * 88; dg = blk * 8 + wid; perm = true; W = t.w_down + (size_t)l * DFF * DM; ldw = DM; nv = DM; K = DFF; WT = t.WT_DN + (size_t)l * DM * DFF; }
    const int k0 = 64 * kb, c = blk * 256 + 4 * lane;
    d.ok = c < nv; d.src = W + (size_t)(k0 + wid * 8) * ldw + c; d.ldw = (size_t)ldw; d.gk = gk ? gk + k0 + wid * 8 : nullptr; d.dst = WT + (size_t)(dg * 32) * K + k0; d.K = K; d.perm = perm; return true;
}
__device__ __forceinline__ void p0_load(const P0Desc& d, f32x4 (&tv)[8]) {
#pragma unroll
    for (int i = 0; i < 8; ++i) tv[i] = d.ok ? *(const f32x4*)(d.src + (size_t)i * d.ldw) : (f32x4){0.f, 0.f, 0.f, 0.f};
}
__device__ __forceinline__ void p0_to_lds(const P0Desc& d, const f32x4 (&tv)[8], LAS float* T, int wid, int lane) {
#pragma unroll
    for (int i = 0; i < 8; ++i) { const float g = d.gk ? d.gk[i] : 1.f; LAS float* tp = T + (wid * 8 + i) * 257 + 4 * lane; tp[0] = tv[i].x * g; tp[1] = tv[i].y * g; tp[2] = tv[i].z * g; tp[3] = tv[i].w * g; }
}
__device__ __forceinline__ void p0_out(const P0Desc& d, const LAS float* T, int wid, int lane) {
    const int c8 = lane & 7;
#pragma unroll
    for (int j = 0; j < 4; ++j) { const int n = (lane >> 3) + 8 * j; const int sc = d.perm ? pg8::perm32(n) : n; const LAS float* sp = T + (8 * c8) * 257 + 32 * wid + sc;
        u32x4 o; o.x = cvt_pk_bf16(sp[0 * 257], sp[1 * 257]); o.y = cvt_pk_bf16(sp[2 * 257], sp[3 * 257]); o.z = cvt_pk_bf16(sp[4 * 257], sp[5 * 257]); o.w = cvt_pk_bf16(sp[6 * 257], sp[7 * 257]);
        *(u32x4*)(d.dst + (size_t)n * d.K + 8 * c8) = o; }
}
__device__ __forceinline__ void rms_row_bf16(const float* xrow, const float* g, bf16_t* orow, int lane) {
    const f32x4* xr = (const f32x4*)xrow + lane; f32x4 v[8]; float s = 0.f;
#pragma unroll
    for (int j = 0; j < 8; ++j) { v[j] = xr[64 * j]; s += (v[j].x * v[j].x + v[j].y * v[j].y) + (v[j].z * v[j].z + v[j].w * v[j].w); }
    const float rstd = rsqrtf(wave_sum(s) * (1.f / DM) + EPS);
    const f32x4* gr = (const f32x4*)g + lane; u32x2* o8 = (u32x2*)orow + lane;
#pragma unroll
    for (int j = 0; j < 8; ++j) { const f32x4 gg = gr[64 * j]; u32x2 w; w.x = cvt_pk_bf16(v[j].x * rstd * gg.x, v[j].y * rstd * gg.y); w.y = cvt_pk_bf16(v[j].z * rstd * gg.z, v[j].w * rstd * gg.w); o8[64 * j] = w; }
}
__device__ __forceinline__ void row_bf16_ss(const float* xrow, bf16_t* orow, float* ss, int lane) {
    const f32x4* xr = (const f32x4*)xrow + lane; f32x4 v[8]; float s = 0.f;
#pragma unroll
    for (int j = 0; j < 8; ++j) { v[j] = xr[64 * j]; s += (v[j].x * v[j].x + v[j].y * v[j].y) + (v[j].z * v[j].z + v[j].w * v[j].w); }
    s = wave_sum(s); u32x2* o8 = (u32x2*)orow + lane;
#pragma unroll
    for (int j = 0; j < 8; ++j) { u32x2 w; w.x = cvt_pk_bf16(v[j].x, v[j].y); w.y = cvt_pk_bf16(v[j].z, v[j].w); o8[64 * j] = w; }
    if (lane == 0) *ss = s;
}
__device__ __forceinline__ void rms_row2_bf16(const float* xa, const float* xb, const float* g, bf16_t* oa, bf16_t* ob, int lane) {
    const f32x4* ra = (const f32x4*)xa + lane; const f32x4* rb = (const f32x4*)xb + lane; f32x4 va[8], vb[8]; float sa = 0.f, sb = 0.f;
#pragma unroll
    for (int j = 0; j < 8; ++j) { va[j] = ra[64 * j]; vb[j] = rb[64 * j]; }
#pragma unroll
    for (int j = 0; j < 8; ++j) { sa += (va[j].x * va[j].x + va[j].y * va[j].y) + (va[j].z * va[j].z + va[j].w * va[j].w); sb += (vb[j].x * vb[j].x + vb[j].y * vb[j].y) + (vb[j].z * vb[j].z + vb[j].w * vb[j].w); }
    const float rsa = rsqrtf(wave_sum(sa) * (1.f / DM) + EPS), rsb = rsqrtf(wave_sum(sb) * (1.f / DM) + EPS);
    const f32x4* gr = (const f32x4*)g + lane; u32x2* pa = (u32x2*)oa + lane; u32x2* pb = (u32x2*)ob + lane;
#pragma unroll
    for (int j = 0; j < 8; ++j) { const f32x4 gg = gr[64 * j]; u32x2 w;
        w.x = cvt_pk_bf16(va[j].x * rsa * gg.x, va[j].y * rsa * gg.y); w.y = cvt_pk_bf16(va[j].z * rsa * gg.z, va[j].w * rsa * gg.w); pa[64 * j] = w;
        w.x = cvt_pk_bf16(vb[j].x * rsb * gg.x, vb[j].y * rsb * gg.y); w.y = cvt_pk_bf16(vb[j].z * rsb * gg.z, vb[j].w * rsb * gg.w); pb[64 * j] = w; }
}
__device__ __forceinline__ void rms_row_f32(const float* xrow, const float* g, float* orow, int lane) {
    const f32x4* xr = (const f32x4*)xrow + lane; f32x4 v[8]; float s = 0.f;
#pragma unroll
    for (int j = 0; j < 8; ++j) { v[j] = xr[64 * j]; s += (v[j].x * v[j].x + v[j].y * v[j].y) + (v[j].z * v[j].z + v[j].w * v[j].w); }
    const float rstd = rsqrtf(wave_sum(s) * (1.f / DM) + EPS);
    const f32x4* gr = (const f32x4*)g + lane; f32x4* o = (f32x4*)orow + lane;
#pragma unroll
    for (int j = 0; j < 8; ++j) { const f32x4 gg = gr[64 * j]; o[64 * j] = v[j] * rstd * gg; }
}

struct EpiIn {
    static constexpr bool PERM = false, AFTER_DRAIN = false;
    bf16_t* PR; float* UC; float* GLRP; float* PRS; const float* SS; float* conv_p;
    __device__ __forceinline__ void operator()(const f32x4 (&acc)[2][2][4][2], const pg8::Unit& u, int wr, int wc, int fr, int fq) const {
        asm volatile("" : "+v"(fr), "+v"(fq), "+s"(wr), "+s"(wc));
        const int row0 = u.pm * 256 + wr * 64 + fr;
        float rs[2][4];
#pragma unroll
        for (int ai = 0; ai < 2; ++ai)
#pragma unroll
            for (int m = 0; m < 4; ++m) rs[ai][m] = rsqrtf(SS[row0 + ai * 128 + m * 16] * (1.f / DM) + EPS);
        if (u.pn == 24) {
            if (wc == 0) {
#pragma unroll
                for (int ai = 0; ai < 2; ++ai)
#pragma unroll
                    for (int m = 0; m < 4; ++m) *(f32x4*)(GLRP + ((size_t)u.sp * MPAD + row0 + ai * 128 + m * 16) * RANK + 4 * fq) = acc[ai][0][m][0] * rs[ai][m];
            }
        } else if (u.sp >= 0) {
            float* rp0 = PRS + ((size_t)u.sp * NS + wr * 64 + fr) * PRSW;
            if (u.pn < 8) {
#pragma unroll
                for (int m = 0; m < 4; ++m) { float* rp = rp0 + (size_t)(m * 16) * PRSW + 1024 + u.pn * 128 + wc * 32 + 8 * fq;
#pragma unroll
                    for (int bj = 0; bj < 2; ++bj)
#pragma unroll
                        for (int n = 0; n < 2; ++n) *(f32x4*)(rp + bj * 1024 + 4 * n) = acc[0][bj][m][n] * rs[0][m]; }
            } else { const int cb = (u.pn < 12 ? 256 * (u.pn - 8) : 3072 + 256 * (u.pn - 12)) + wc * 32 + 8 * fq;
#pragma unroll
                for (int m = 0; m < 4; ++m) { float* rp = rp0 + (size_t)(m * 16) * PRSW + cb;
#pragma unroll
                    for (int bj = 0; bj < 2; ++bj)
#pragma unroll
                        for (int n = 0; n < 2; ++n) *(f32x4*)(rp + bj * 128 + 4 * n) = acc[0][bj][m][n] * rs[0][m]; }
            }
        } else if (u.pn < 8) {
#pragma unroll
            for (int ai = 0; ai < 2; ++ai)
#pragma unroll
                for (int m = 0; m < 4; ++m) { const int row = row0 + ai * 128 + m * 16, cc = u.pn * 128 + wc * 32 + 8 * fq; bf16_t* rp = (bf16_t*)UC + (size_t)row * CONVD + cc; const float r2 = rs[ai][m] * rs[ai][m]; const int p = row & (SEQ - 1);
                    const f32x4 u0 = acc[ai][0][m][0] * acc[ai][1][m][0] * r2, u1 = acc[ai][0][m][1] * acc[ai][1][m][1] * r2; u32x4 w;
                    w.x = cvt_pk_bf16(u0.x, u0.y); w.y = cvt_pk_bf16(u0.z, u0.w); w.z = cvt_pk_bf16(u1.x, u1.y); w.w = cvt_pk_bf16(u1.z, u1.w); EPI_ST((u32x4*)rp, w);
                    if (p >= SEQ - 2) { float* sp = conv_p + ((size_t)(row >> 11) * 2 + (p - (SEQ - 2))) * CONVD + cc; *(f32x4*)sp = u0; *(f32x4*)(sp + 4) = u1; } }
        } else {
#pragma unroll
            for (int ai = 0; ai < 2; ++ai)
#pragma unroll
                for (int m = 0; m < 4; ++m) { bf16_t* rp = PR + (size_t)(row0 + ai * 128 + m * 16) * PRW + (u.pn - 8) * 256 + wc * 32 + 8 * fq; const float r1 = rs[ai][m];
#pragma unroll
                    for (int bj = 0; bj < 2; ++bj) { const f32x4 v0 = acc[ai][bj][m][0] * r1, v1 = acc[ai][bj][m][1] * r1; u32x4 w;
                        w.x = cvt_pk_bf16(v0[0], v0[1]); w.y = cvt_pk_bf16(v0[2], v0[3]); w.z = cvt_pk_bf16(v1[0], v1[1]); w.w = cvt_pk_bf16(v1[2], v1[3]);
                        EPI_ST((u32x4*)(rp + bj * 128), w); } }
        }
    }
};
template <int N> __device__ __forceinline__ float ror16(float v) { return __int_as_float(__builtin_amdgcn_update_dpp(0, __float_as_int(v), 0x120 + N, 0xF, 0xF, false)); }
struct EpiUp {
    static constexpr bool PERM = false, AFTER_DRAIN = false;
    bf16_t* H; const float* cw; const float* cb; float* TAIL; float* HEAD; const float* st_in; float* ffn_p; float* ffn_s; LAS float* halo; const float* SS;
    __device__ __forceinline__ void operator()(const f32x4 (&acc)[2][2][4][2], const pg8::Unit& u, int wr, int wc, int fr, int fq) const {
        asm volatile("" : "+v"(fr), "+v"(fq), "+s"(wr), "+s"(wc));
        const int col = u.pn * 128 + wc * 32 + 8 * fq; const int lc = wc * 32 + 8 * fq;
        if (u.pm == 32) {
            if (!RUN_FIX) __builtin_amdgcn_s_barrier();
#pragma unroll
            for (int n = 0; n < 2; ++n) { const int cn = col + 4 * n;
                const f32x4 w0 = *(const f32x4*)(cw + cn), w1 = *(const f32x4*)(cw + DFF + cn), w2 = *(const f32x4*)(cw + 2 * DFF + cn), bb = *(const f32x4*)(cb + cn);
#pragma unroll
                for (int m = 0; m < 4; ++m) { const int s = wr * 64 + m * 16 + fr; const float* sp = st_in + (size_t)s * 2 * DFF + cn; float* op = ffn_s + (size_t)s * 2 * DFF + cn;
                    const float r1 = rsqrtf(SS[MP + s] * (1.f / DM) + EPS);
                    const f32x4 s0 = *(const f32x4*)sp, s1 = *(const f32x4*)(sp + DFF), uu = acc[0][0][m][n] * r1, vv = acc[0][1][m][n] * r1;
                    *(f32x4*)op = s1; *(f32x4*)(op + DFF) = uu;
                    const f32x4 cu = s0 * w0 + s1 * w1 + uu * w2 + bb; u32x2 hw;
                    hw.x = cvt_pk_bf16(silu_f(cu[0]) * vv[0], silu_f(cu[1]) * vv[1]); hw.y = cvt_pk_bf16(silu_f(cu[2]) * vv[2], silu_f(cu[3]) * vv[3]);
                    *(u32x2*)(H + (size_t)(MP + s) * DFF + cn) = hw; *(u32x2*)(H + (size_t)(MP + 128 + s) * DFF + cn) = (u32x2){0u, 0u}; }
                asm volatile("" ::: "memory"); }
            return;
        }
        const int row0 = u.pm * 256 + wr * 64 + fr;
        float rs[2][4];
#pragma unroll
        for (int ai = 0; ai < 2; ++ai)
#pragma unroll
            for (int m = 0; m < 4; ++m) rs[ai][m] = rsqrtf(SS[row0 + ai * 128 + m * 16] * (1.f / DM) + EPS);
        if (!RUN_FIX) {
        if (fr >= 14) {
#pragma unroll
            for (int ai = 0; ai < 2; ++ai)
#pragma unroll
                for (int n = 0; n < 2; ++n) *(LAS f32x4*)(halo + ((2 * ai + wr) * 2 + (fr - 14)) * 128 + lc + 4 * n) = acc[ai][0][3][n] * rs[ai][3];
        }
        asm volatile("s_waitcnt lgkmcnt(0)" ::: "memory"); __builtin_amdgcn_s_barrier(); asm volatile("" ::: "memory");
        }
        u32x2 hkeep[2][4];
#pragma unroll
        for (int n = 0; n < 2; ++n) { const int cn = col + 4 * n;
            const f32x4 w0 = *(const f32x4*)(cw + cn), w1 = *(const f32x4*)(cw + DFF + cn), w2 = *(const f32x4*)(cw + 2 * DFF + cn), bb = *(const f32x4*)(cb + cn);
#pragma unroll
            for (int ai = 0; ai < 2; ++ai) {
                const int rho = 2 * ai + wr; const f32x4 z = {0.f, 0.f, 0.f, 0.f};
                const f32x4 h0 = (!RUN_FIX && rho > 0) ? *(const LAS f32x4*)(halo + ((rho - 1) * 2 + 0) * 128 + lc + 4 * n) : z, h1 = (!RUN_FIX && rho > 0) ? *(const LAS f32x4*)(halo + ((rho - 1) * 2 + 1) * 128 + lc + 4 * n) : z;
                f32x4 pu = {0.f, 0.f, 0.f, 0.f};
#pragma unroll
                for (int m = 0; m < 4; ++m) { const f32x4 uu = acc[ai][0][m][n] * rs[ai][m], vv = acc[ai][1][m][n] * rs[ai][m]; f32x4 p1, p2;
#pragma unroll
                    for (int e = 0; e < 4; ++e) { const float c1 = ror16<1>(uu[e]), c2 = ror16<2>(uu[e]); float q1, q2;
                        if (m > 0) { q1 = ror16<1>(pu[e]); q2 = ror16<2>(pu[e]); }
                        else { q1 = h1[e]; q2 = fr == 1 ? h1[e] : h0[e]; }
                        p1[e] = fr >= 1 ? c1 : q1; p2[e] = fr >= 2 ? c2 : q2; }
                    const f32x4 cu = p2 * w0 + p1 * w1 + uu * w2 + bb; u32x2 hw;
                    hw.x = cvt_pk_bf16(silu_f(cu[0]) * vv[0], silu_f(cu[1]) * vv[1]); hw.y = cvt_pk_bf16(silu_f(cu[2]) * vv[2], silu_f(cu[3]) * vv[3]);
                    if (n == 0) hkeep[ai][m] = hw; else { u32x4 h4; h4.x = hkeep[ai][m].x; h4.y = hkeep[ai][m].y; h4.z = hw.x; h4.w = hw.y; EPI_ST((u32x4*)(H + (size_t)(row0 + ai * 128 + m * 16) * DFF + col), h4); } pu = uu;
                    if (RUN_FIX) { const int R = u.pm * 4 + rho;
                        if (m == 3 && fr >= 14) { *(f32x4*)(TAIL + ((size_t)R * 2 + (fr - 14)) * DFF + cn) = uu; if ((R & 31) == 31) *(f32x4*)(ffn_p + ((size_t)(R >> 5) * 2 + (fr - 14)) * DFF + cn) = uu; }
                        if (m == 0 && fr < 2) { float* hp = HEAD + ((size_t)R * 2 + fr) * 2 * DFF + cn; *(f32x4*)hp = uu; *(f32x4*)(hp + DFF) = vv; } } }
            }
            asm volatile("" ::: "memory"); }
        if (!RUN_FIX && wr == 1 && fr >= 14) {
            const f32x4 t0 = acc[1][0][3][0] * rs[1][3], t1 = acc[1][0][3][1] * rs[1][3];
            float* tp = TAIL + ((size_t)u.pm * 2 + (fr - 14)) * DFF + col; *(f32x4*)tp = t0; *(f32x4*)(tp + 4) = t1;
            if ((u.pm & 7) == 7) { float* sp = ffn_p + ((size_t)(u.pm >> 3) * 2 + (fr - 14)) * DFF + col; *(f32x4*)sp = t0; *(f32x4*)(sp + 4) = t1; }
        }
        if (!RUN_FIX && wr == 0 && fr < 2) {
            float* hp = HEAD + ((size_t)u.pm * 2 + fr) * 2 * DFF + col; const float r1 = rs[0][0]; *(f32x4*)hp = acc[0][0][0][0] * r1; *(f32x4*)(hp + 4) = acc[0][0][0][1] * r1; *(f32x4*)(hp + DFF) = acc[0][1][0][0] * r1; *(f32x4*)(hp + DFF + 4) = acc[0][1][0][1] * r1;
        }
    }
};
struct EpiRes {
    static constexpr bool PERM = false, AFTER_DRAIN = false;
    const float* baseP; float* out; float* XSP; bf16_t* XB; float* SS;
    __device__ __forceinline__ void operator()(const f32x4 (&acc)[2][2][4][2], const pg8::Unit& u, int wr, int wc, int fr, int fq) const {
        asm volatile("" : "+v"(fr), "+v"(fq), "+s"(wr), "+s"(wc));
        const int row0 = u.pm * 256 + wr * 64 + fr; const int col0 = u.pn * 256 + wc * 32 + 8 * fq;
        if (u.sp >= 0) {
#pragma unroll
            for (int m = 0; m < 4; ++m) { float* op = XSP + ((size_t)u.sp * NS + wr * 64 + m * 16 + fr) * DM + col0;
#pragma unroll
                for (int bj = 0; bj < 2; ++bj)
#pragma unroll
                    for (int n = 0; n < 2; ++n) *(f32x4*)(op + bj * 128 + 4 * n) = acc[0][bj][m][n]; }
            return;
        }
#pragma unroll
        for (int ai = 0; ai < 2; ++ai)
#pragma unroll
            for (int m = 0; m < 4; ++m) { const int row = row0 + ai * 128 + m * 16;
                { bf16_t* xb = XB + (size_t)row * DM + col0; float ss = 0.f;
#pragma unroll
                    for (int bj = 0; bj < 2; ++bj) { f32x4 b0, b1;
                        if (baseP) { const float* bp = baseP + (size_t)row * DM + col0 + bj * 128; b0 = *(const f32x4*)bp; b1 = *(const f32x4*)(bp + 4); }
                        else { const u32x4 bw = *(const u32x4*)(xb + bj * 128); b0 = (f32x4){bf_lo(bw.x), bf_hi(bw.x), bf_lo(bw.y), bf_hi(bw.y)}; b1 = (f32x4){bf_lo(bw.z), bf_hi(bw.z), bf_lo(bw.w), bf_hi(bw.w)}; }
                        const f32x4 v0 = b0 + acc[ai][bj][m][0], v1 = b1 + acc[ai][bj][m][1];
                        ss += ((v0.x * v0.x + v0.y * v0.y) + (v0.z * v0.z + v0.w * v0.w)) + ((v1.x * v1.x + v1.y * v1.y) + (v1.z * v1.z + v1.w * v1.w));
                        u32x4 w; w.x = cvt_pk_bf16(v0.x, v0.y); w.y = cvt_pk_bf16(v0.z, v0.w); w.z = cvt_pk_bf16(v1.x, v1.y); w.w = cvt_pk_bf16(v1.z, v1.w); EPI_ST((u32x4*)(xb + bj * 128), w); }
                    if (SS) { ss += __shfl_xor(ss, 16); ss += __shfl_xor(ss, 32); if (fq == 0) SS[(size_t)row * 32 + u.pn * 4 + wc] = ss; } }
                asm volatile("" ::: "memory"); }
    }
};

#define MFMA16(x, y, c) __builtin_amdgcn_mfma_f32_16x16x32_bf16((x), (y), (c), 0, 0, 0)
typedef short s16x4 __attribute__((ext_vector_type(4)));
template <int RS> __device__ __forceinline__ bf16x8 tr_frag(const LAS bf16_t* T, int c, int ks, int lane) {
#ifdef TR_GATHER
    const int g = lane >> 4; const LAS bf16_t* a0 = T + (32 * ks + 8 * g) * RS + 16 * c + (lane & 15); bf16x8 o;
#pragma unroll
    for (int j = 0; j < 8; ++j) o[j] = (short)a0[j * RS];
    return o;
#else
    const int g = lane >> 4, qq = (lane & 15) >> 2, p = lane & 3; const LAS bf16_t* a0 = T + (32 * ks + 8 * g + qq) * RS + 16 * c + 4 * p;
    unsigned addr = (unsigned)(size_t)a0; asm volatile("" : "+v"(addr));
    const LAS bf16_t* a1 = (const LAS bf16_t*)(size_t)addr;
    s16x4 t0 = __builtin_amdgcn_ds_read_tr16_b64_v4i16((LAS s16x4*)a1), t1 = __builtin_amdgcn_ds_read_tr16_b64_v4i16((LAS s16x4*)(a1 + 4 * RS));
    asm volatile("" : "+v"(t0), "+v"(t1) : "v"(addr));
    return __builtin_shufflevector(t0, t1, 0, 1, 2, 3, 4, 5, 6, 7);
#endif
}
__device__ __forceinline__ void stage_v(LAS bf16_t* Vn, const bf16_t* PR, int tok0, int h, int tid) {
#pragma unroll
    for (int i = 0; i < 4; ++i) { const int id = tid + 512 * i, j = id >> 5, cc = id & 31; *(LAS u32x4*)(Vn + j * 272 + cc * 8) = *(const u32x4*)(PR + (size_t)(tok0 + j) * PRW + 2048 + h * DV + cc * 8); }
}
__device__ __forceinline__ void gla_passA(LAS unsigned char* lds, int uidx, const bf16_t* PR, const float* GLRP, const float* w2, const float* gb,
                                          bf16_t* SUB, float* EB, bf16_t* QT, bf16_t* AM, int tid, int wid, int lane) {
    const int b = uidx >> 7, c = (uidx >> 2) & 31, h = uidx & 3; const int tok0 = b * SEQ + c * 64; const int bh = b * 4 + h;
    LAS float* Bc = (LAS float*)lds;
    LAS float* bCs = Bc + 64 * 129;
    LAS bf16_t* Qs = (LAS bf16_t*)(lds + 33536);
    LAS bf16_t* Ks = Qs + 64 * 136;
    LAS bf16_t* Kh = Ks + 64 * 136;
    LAS bf16_t* Vn = Kh + 64 * 136;
    const int r = lane & 15, q = lane >> 4;
    const bf16_t* qp = PR + (size_t)(tok0 + (tid >> 3)) * PRW + 1024 + h * DK + (tid & 7) * 16;
    const u32x4 qa = *(const u32x4*)qp, qb = *(const u32x4*)(qp + 8), ka = *(const u32x4*)(qp + 512), kb = *(const u32x4*)(qp + 520);
    u32x4 vreg[4];
#pragma unroll
    for (int i = 0; i < 4; ++i) { const int id = tid + 512 * i; vreg[i] = *(const u32x4*)(PR + (size_t)(tok0 + (id >> 5)) * PRW + 2048 + h * DV + (id & 31) * 8); }
    LAS float* Gs = (LAS float*)(lds + 120576);
    LAS float* Tt = Gs + 64 * 16;
    if (tid < 256) { const int t = tid >> 2, r4 = (tid & 3) * 4; const float* gp = GLRP + (size_t)(tok0 + t) * RANK + r4; f32x4 g = *(const f32x4*)gp;
#pragma unroll
        for (int sp = 1; sp < NSP1; ++sp) g += *(const f32x4*)(gp + (size_t)sp * MPAD * RANK);
        *(LAS f32x4*)(Gs + t * 16 + r4) = g; }
    const int kcol = tid & 127, tg = tid >> 7;
    float wk[16];
#pragma unroll
    for (int rr = 0; rr < 16; ++rr) wk[rr] = w2[rr * QKD + h * DK + kcol];
    const float bias = gb[h * DK + kcol];
#pragma unroll
    for (int i = 0; i < 4; ++i) { const int id = tid + 512 * i; *(LAS u32x4*)(Vn + (id >> 5) * 272 + (id & 31) * 8) = vreg[i]; }
    __syncthreads();
    { float run = 0.f;
#pragma unroll 4
      for (int i = 0; i < 16; ++i) { const int t = 16 * tg + i; const LAS f32x4* gr = (const LAS f32x4*)(Gs + t * 16); const f32x4 a0 = gr[0], a1 = gr[1], a2 = gr[2], a3 = gr[3];
          float z = bias;
          z += a0.x * wk[0] + a0.y * wk[1] + a0.z * wk[2] + a0.w * wk[3]; z += a1.x * wk[4] + a1.y * wk[5] + a1.z * wk[6] + a1.w * wk[7];
          z += a2.x * wk[8] + a2.y * wk[9] + a2.z * wk[10] + a2.w * wk[11]; z += a3.x * wk[12] + a3.y * wk[13] + a3.z * wk[14] + a3.w * wk[15];
          run += logsig_f(z) * (1.f / 16.f); Bc[t * 129 + kcol] = run; }
      Tt[tg * 128 + kcol] = run; }
    __syncthreads();
    {
        const int j = tid >> 3, kr = (tid & 7) * 16, jg = j >> 4;
        const float scale = 0.08838834764831845f;
        u32x4 oq[2], ok[2], oh[2];
#pragma unroll
        for (int e4 = 0; e4 < 4; ++e4) {
            const f32x4 t0 = *(const LAS f32x4*)(Tt + 0 * 128 + kr + 4 * e4), t1 = *(const LAS f32x4*)(Tt + 1 * 128 + kr + 4 * e4), t2 = *(const LAS f32x4*)(Tt + 2 * 128 + kr + 4 * e4), t3 = *(const LAS f32x4*)(Tt + 3 * 128 + kr + 4 * e4);
            const f32x4 zz = {0.f, 0.f, 0.f, 0.f}; const f32x4 off = (jg > 0 ? t0 : zz) + (jg > 1 ? t1 : zz) + (jg > 2 ? t2 : zz), bc = (t0 + t1) + (t2 + t3);
#pragma unroll
            for (int eh = 0; eh < 2; ++eh) { const int e2 = 2 * e4 + eh; const unsigned qw = e2 < 4 ? qa[e2] : qb[e2 - 4], kw = e2 < 4 ? ka[e2] : kb[e2 - 4];
                const int k = kr + 2 * e2;
                const float b0 = Bc[j * 129 + k] + off[2 * eh], b1 = Bc[j * 129 + k + 1] + off[2 * eh + 1], c0 = bc[2 * eh], c1 = bc[2 * eh + 1];
                const float q0 = bf_lo(qw) * scale * __expf(b0), q1 = bf_hi(qw) * scale * __expf(b1);
                const float k0 = bf_lo(kw), k1 = bf_hi(kw);
                const unsigned pq = cvt_pk_bf16(q0, q1), pk = cvt_pk_bf16(k0 * __expf(-b0), k1 * __expf(-b1)), ph = cvt_pk_bf16(k0 * __expf(c0 - b0), k1 * __expf(c1 - b1));
                if (e2 < 4) { oq[0][e2] = pq; ok[0][e2] = pk; oh[0][e2] = ph; } else { oq[1][e2 - 4] = pq; ok[1][e2 - 4] = pk; oh[1][e2 - 4] = ph; } }
        }
        *(LAS u32x4*)(Qs + j * 136 + kr) = oq[0]; *(LAS u32x4*)(Qs + j * 136 + kr + 8) = oq[1];
        *(LAS u32x4*)(Ks + j * 136 + kr) = ok[0]; *(LAS u32x4*)(Ks + j * 136 + kr + 8) = ok[1];
        *(LAS u32x4*)(Kh + j * 136 + kr) = oh[0]; *(LAS u32x4*)(Kh + j * 136 + kr + 8) = oh[1];
        bf16_t* qt = QT + (size_t)(tok0 + j) * QKD + h * DK + kr; *(u32x4*)qt = oq[0]; *(u32x4*)(qt + 8) = oq[1];
        if (tid < DK) EB[((size_t)bh * NCH + c) * DK + tid] = __expf((Tt[tid] + Tt[128 + tid]) + (Tt[256 + tid] + Tt[384 + tid]));
    }
    __syncthreads();
    {
        const int it = wid >> 1, jt0 = (wid & 1) * 2; f32x4 a[2] = {{0.f, 0.f, 0.f, 0.f}, {0.f, 0.f, 0.f, 0.f}};
#pragma unroll
        for (int ks = 0; ks < 4; ++ks) { const bf16x8 y = *(const LAS bf16x8*)(Qs + (16 * it + r) * 136 + 32 * ks + 8 * q);
#pragma unroll
            for (int jj = 0; jj < 2; ++jj) { const bf16x8 x = *(const LAS bf16x8*)(Ks + (16 * (jt0 + jj) + r) * 136 + 32 * ks + 8 * q); a[jj] = MFMA16(x, y, a[jj]); } }
        const int i = 16 * it + r;
#pragma unroll
        for (int jj = 0; jj < 2; ++jj) { const int jb = 16 * (jt0 + jj) + 4 * q; u32x2 w;
            w.x = cvt_pk_bf16(jb + 0 <= i ? a[jj][0] : 0.f, jb + 1 <= i ? a[jj][1] : 0.f); w.y = cvt_pk_bf16(jb + 2 <= i ? a[jj][2] : 0.f, jb + 3 <= i ? a[jj][3] : 0.f);
            *(u32x2*)(AM + (size_t)uidx * 4096 + i * 64 + jb) = w; }
    }
    {
        f32x4 acc[2][8];
#pragma unroll
        for (int a = 0; a < 2; ++a)
#pragma unroll
            for (int yt = 0; yt < 8; ++yt) acc[a][yt] = (f32x4){0.f, 0.f, 0.f, 0.f};
#pragma unroll
        for (int ks = 0; ks < 2; ++ks) { bf16x8 x[2];
#pragma unroll
            for (int a = 0; a < 2; ++a) x[a] = tr_frag<272>(Vn, 2 * wid + a, ks, lane);
#pragma unroll
            for (int yt = 0; yt < 8; ++yt) { const bf16x8 y = tr_frag<136>(Kh, yt, ks, lane);
#pragma unroll
                for (int a = 0; a < 2; ++a) acc[a][yt] = MFMA16(x[a], y, acc[a][yt]); } }
        bf16_t* sp = SUB + ((size_t)bh * NCH + c) * (DK * DV);
#pragma unroll
        for (int a = 0; a < 2; ++a)
#pragma unroll
            for (int yt = 0; yt < 8; ++yt) { u32x2 w; w.x = cvt_pk_bf16(acc[a][yt][0], acc[a][yt][1]); w.y = cvt_pk_bf16(acc[a][yt][2], acc[a][yt][3]); *(u32x2*)(sp + (16 * yt + r) * DV + 32 * wid + 16 * a + 4 * q) = w; }
    }
    __syncthreads();
}
__device__ __forceinline__ void gla_passC(LAS unsigned char* lds, int uidx, const bf16_t* PR, const bf16_t* SUB, const bf16_t* QT, const bf16_t* AM, const float* gn  ,
                                          bf16_t* Y, int tid, int wid, int lane) {
    const int b = uidx >> 7, c = (uidx >> 2) & 31, h = uidx & 3; const int tok0 = b * SEQ + c * 64; const int bh = b * 4 + h;
    LAS bf16_t* Qs = (LAS bf16_t*)lds;
    LAS bf16_t* As = (LAS bf16_t*)(lds + 17408);
    LAS bf16_t* Vn = (LAS bf16_t*)(lds + 26624);
    LAS bf16_t* Sn = (LAS bf16_t*)(lds + 61440);
    LAS float* Of = (LAS float*)(lds + 61440);
    const int r = lane & 15, q = lane >> 4;
    u32x4 ogr[4];
    { const bf16_t* gp0 = PR + (size_t)(tok0 + (tid >> 3)) * PRW + 3072 + h * DV + (tid & 7) * 32;
#pragma unroll
      for (int j = 0; j < 4; ++j) ogr[j] = *(const u32x4*)(gp0 + 8 * j); }
    { const bf16_t* sp = SUB + ((size_t)bh * NCH + c) * (DK * DV);
#pragma unroll
      for (int i = 0; i < 8; ++i) { const int id = tid + 512 * i, k = id >> 5, cc = id & 31; *(LAS u32x4*)(Sn + k * 272 + cc * 8) = *(const u32x4*)(sp + k * DV + cc * 8); } }
#pragma unroll
    for (int i = 0; i < 2; ++i) { const int id = tid + 512 * i, row = id >> 4, cc = id & 15; *(LAS u32x4*)(Qs + row * 136 + cc * 8) = *(const u32x4*)(QT + (size_t)(tok0 + row) * QKD + h * DK + cc * 8); }
    { const int row = tid >> 3, cc = tid & 7; *(LAS u32x4*)(As + row * 72 + cc * 8) = *(const u32x4*)(AM + (size_t)uidx * 4096 + row * 64 + cc * 8); }
    stage_v(Vn, PR, tok0, h, tid);
    __syncthreads();
    f32x4 acc[2][4];
#pragma unroll
    for (int a = 0; a < 2; ++a)
#pragma unroll
        for (int it = 0; it < 4; ++it) acc[a][it] = (f32x4){0.f, 0.f, 0.f, 0.f};
#pragma unroll
    for (int ks = 0; ks < 4; ++ks) { bf16x8 x[2];
#pragma unroll
        for (int a = 0; a < 2; ++a) x[a] = tr_frag<272>(Sn, 2 * wid + a, ks, lane);
#pragma unroll
        for (int it = 0; it < 4; ++it) { const bf16x8 y = *(const LAS bf16x8*)(Qs + (16 * it + r) * 136 + 32 * ks + 8 * q);
#pragma unroll
            for (int a = 0; a < 2; ++a) acc[a][it] = MFMA16(x[a], y, acc[a][it]); } }
#pragma unroll
    for (int ks = 0; ks < 2; ++ks) { bf16x8 x[2];
#pragma unroll
        for (int a = 0; a < 2; ++a) x[a] = tr_frag<272>(Vn, 2 * wid + a, ks, lane);
#pragma unroll
        for (int it = 0; it < 4; ++it) { const bf16x8 y = *(const LAS bf16x8*)(As + (16 * it + r) * 72 + 32 * ks + 8 * q);
#pragma unroll
            for (int a = 0; a < 2; ++a) acc[a][it] = MFMA16(x[a], y, acc[a][it]); } }
    __syncthreads();
#pragma unroll
    for (int a = 0; a < 2; ++a)
#pragma unroll
        for (int it = 0; it < 4; ++it) *(LAS f32x4*)(Of + (16 * it + r) * 260 + 32 * wid + 16 * a + 4 * q) = acc[a][it];
    __syncthreads();
    { const int i = tid >> 3, seg = tid & 7; f32x4 o[8]; float ss = 0.f;
#pragma unroll
      for (int j = 0; j < 8; ++j) { o[j] = *(const LAS f32x4*)(Of + i * 260 + seg * 32 + 4 * j); ss += (o[j].x * o[j].x + o[j].y * o[j].y) + (o[j].z * o[j].z + o[j].w * o[j].w); }
      ss += __shfl_xor(ss, 1); ss += __shfl_xor(ss, 2); ss += __shfl_xor(ss, 4);
      const float rstd = rsqrtf(ss * (1.f / DV) + EPS);
      const bf16_t* gp = PR + (size_t)(tok0 + i) * PRW + 3072 + h * DV + seg * 32; const float* gnp = gn + h * DV + seg * 32; bf16_t* yp = Y + (size_t)(tok0 + i) * DM + 1024 + h * DV + seg * 32;
#pragma unroll
      for (int j = 0; j < 4; ++j) { const u32x4 g = ogr[j]; const f32x4 n0 = *(const f32x4*)(gnp + 8 * j), n1 = *(const f32x4*)(gnp + 8 * j + 4); const f32x4 a0 = o[2 * j], a1 = o[2 * j + 1]; u32x4 w;
          w.x = cvt_pk_bf16(a0.x * rstd * n0.x * silu_f(bf_lo(g.x)), a0.y * rstd * n0.y * silu_f(bf_hi(g.x)));
          w.y = cvt_pk_bf16(a0.z * rstd * n0.z * silu_f(bf_lo(g.y)), a0.w * rstd * n0.w * silu_f(bf_hi(g.y)));
          w.z = cvt_pk_bf16(a1.x * rstd * n1.x * silu_f(bf_lo(g.z)), a1.y * rstd * n1.y * silu_f(bf_hi(g.z)));
          w.w = cvt_pk_bf16(a1.z * rstd * n1.z * silu_f(bf_lo(g.w)), a1.w * rstd * n1.w * silu_f(bf_hi(g.w)));
          *(u32x4*)(yp + 8 * j) = w; } }
    __syncthreads();
}
__device__ __forceinline__ float prs_sum(const float* PRS, int s, int col) { float v = 0.f;
#pragma unroll
    for (int sp = 0; sp < NSP1; ++sp) v += PRS[((size_t)sp * NS + s) * PRSW + col];
    return v; }
__device__ __forceinline__ f32x4 prs_sum4(const float* PRS, int s, int col) { f32x4 v = {0.f, 0.f, 0.f, 0.f};
#pragma unroll
    for (int sp = 0; sp < NSP1; ++sp) v += *(const f32x4*)(PRS + ((size_t)sp * NS + s) * PRSW + col);
    return v; }
template <bool WITH_O> __device__ __forceinline__ void gla_sample(LAS unsigned char* lds, int uidx, const float* PRS, const float* GLRP, const float* w2, const float* gb, const float* gn,
                                           const float* s_in  , float* s_out  , bf16_t* Y, int tid, int wid, int lane) {
    const int s = uidx >> 2, h = uidx & 3; const int row = MP + s;
    LAS float* smA = (LAS float*)lds; LAS float* smK = smA + 128; LAS float* smQ = smK + 128; LAS float* smO = smQ + 128; LAS float* smR = smO + 2048;
    const size_t sb = ((size_t)(s * 4 + h) * DK) * DV + (tid & 63) * 4; f32x4 S[16];
#pragma unroll
    for (int kk = 0; kk < 16; ++kk) S[kk] = __builtin_nontemporal_load((const f32x4*)(s_in + sb + (size_t)(16 * wid + kk) * DV));
    if (tid < DK) { const int col = h * DK + tid; float z = gb[col];
#pragma unroll
        for (int rr = 0; rr < RANK; ++rr) { float g = 0.f;
#pragma unroll
            for (int sp = 0; sp < NSP1; ++sp) g += GLRP[((size_t)sp * MPAD + row) * RANK + rr];
            z += g * w2[rr * QKD + col]; }
        smA[tid] = __expf(logsig_f(z) * (1.f / 16.f)); smK[tid] = prs_sum(PRS, s, 3584 + col); if (WITH_O) smQ[tid] = prs_sum(PRS, s, 3072 + col) * 0.08838834764831845f; }
    const int dv4 = (tid & 63) * 4; const f32x4 v = prs_sum4(PRS, s, 4096 + h * DV + dv4);
    __syncthreads();
    f32x4 o = {0.f, 0.f, 0.f, 0.f};
#pragma unroll
    for (int kk = 0; kk < 16; ++kk) { const int k = 16 * wid + kk; const f32x4 sn = S[kk] * smA[k] + v * smK[k]; if (!WITH_O || !DEFER_STATE) __builtin_nontemporal_store(sn, (f32x4*)(s_out + sb + (size_t)k * DV)); if (WITH_O) o += sn * smQ[k]; }
    if (!WITH_O) { __syncthreads(); return; }
    *(LAS f32x4*)(smO + wid * 256 + dv4) = o;
    __syncthreads();
    float oo = 0.f;
    if (tid < 256) {
#pragma unroll
        for (int w = 0; w < 8; ++w) oo += smO[w * 256 + tid];
        const float ss = wave_sum(oo * oo); if (lane == 0) smR[wid] = ss; }
    __syncthreads();
    if (tid < 256) { const float tot = (smR[0] + smR[1]) + (smR[2] + smR[3]); const float rstd = rsqrtf(tot * (1.f / DV) + EPS);
        const float og = prs_sum(PRS, s, 5120 + h * DV + tid); Y[(size_t)row * DM + 1024 + h * DV + tid] = f2bf(oo * rstd * gn[h * DV + tid] * silu_f(og)); }
    __syncthreads();
}
__device__ __forceinline__ void sample_assemble(const float* base, const float* XSP, int nsp, int s, float* xr, int lane) {
    const f32x4* br = (const f32x4*)base + lane; f32x4* o = (f32x4*)xr + lane;
#pragma unroll
    for (int j = 0; j < 8; ++j) { f32x4 v = br[64 * j];
        for (int sp = 0; sp < nsp; ++sp) v += *((const f32x4*)(XSP + ((size_t)sp * NS + s) * DM) + lane + 64 * j);
        o[64 * j] = v; }
}

template <int PH> struct MixOrder {
    pg8::StaticOrder so; int nfull, ntfull;
    __device__ __forceinline__ void init(int Ncols, int ntf, int G, int c) { so.init(MP, Ncols, G, c); nfull = so.nwg; ntfull = ntf; }
    __device__ __forceinline__ bool next(int i, pg8::Unit& u) const {
        const long L = (long)i * so.G + so.c; int pm = 32, pn = 0, sp = -1, k0 = 0, nt = ntfull; bool ok = true;
        if (L < nfull) { pg8::Unit t; so.next(i, t); pm = t.pm; pn = t.pn; }
        else { const int mi = (int)(L - nfull);
            if (PH == 1) { ok = mi < 57 * NSP1;
                const bool isg = mi < 33 * NSP1; const int m2 = isg ? mi : mi - 33 * NSP1; const int qd = m2 / NSP1; sp = m2 - qd * NSP1; pm = isg ? qd : 32; pn = isg ? 24 : qd; nt = 32 / NSP1; k0 = sp * (32 / NSP1); }
            else if (PH == 2) { ok = mi < 64; pn = mi >> 3; sp = mi & 7; k0 = sp * 4; nt = 4; }
            else if (PH == 3) { ok = mi < 44; pn = mi; nt = 32; }
            else { ok = mi < 88; pn = mi / 11; sp = mi - 11 * pn; k0 = sp * 8; nt = 8; }
        }
        u.pm = pm; u.pn = pn; u.sp = sp; u.k0 = k0; u.nt = nt; return ok;
    }
    __device__ __forceinline__ void a_ready(const pg8::Unit&) const {}
    __device__ __forceinline__ void done(const pg8::Unit&) const {}
};

#define XB_TMO      128
#define XB_XCNT(j)  (256  + 64 * (j))
#define XB_XSUB(j)  (1280 + 64 * (j))
#define XB_XGEN(j)  (2304 + 64 * (j))
#define XB_TOP      3328
#define XB_TOPGEN   3392
#define XCD_BAR_WORDS 3456
#define XB_SPIN_CAP (1u << 18)

__device__ __forceinline__ unsigned xb_ld(unsigned* p)              { return __hip_atomic_load(p, __ATOMIC_RELAXED, __HIP_MEMORY_SCOPE_AGENT); }
__device__ __forceinline__ unsigned xb_add(unsigned* p, unsigned v) { return __hip_atomic_fetch_add(p, v, __ATOMIC_RELAXED, __HIP_MEMORY_SCOPE_AGENT); }
__device__ __forceinline__ unsigned xb_xcc_id() { return (unsigned)__builtin_amdgcn_s_getreg((3 << 11) | 20) & 0xFu; }
#define XB_SPIN(cond, bar) do { unsigned _sp = 0; while (cond) { \
    if ((++_sp & 255u) == 0u) { if (xb_ld(&(bar)[XB_TMO])) break; if (_sp > XB_SPIN_CAP) { atomicAdd(&(bar)[XB_TMO], 1u); break; } } } } while (0)

struct XcdBarrier {
    unsigned* bar; unsigned x;
    volatile LAS unsigned* st;
};

__device__ __forceinline__ XcdBarrier xcd_barrier_post(unsigned* bar, volatile LAS unsigned* st) {
    XcdBarrier b; b.bar = bar; b.x = xb_xcc_id(); b.st = st;
    if (threadIdx.x == 0) (void)xb_add(&bar[XB_XCNT(b.x)], 1u);
    return b;
}
__device__ __forceinline__ void xcd_barrier_complete(unsigned* bar, unsigned x, unsigned& nloc, unsigned& nx) {
    const unsigned G = gridDim.x * gridDim.y * gridDim.z;
    unsigned sum, cnt, mine, sp = 0u;
    for (;;) {
        sum = 0u; cnt = 0u; mine = 0u;
#pragma unroll
        for (unsigned j = 0; j < 16; ++j) { const unsigned c = xb_ld(&bar[XB_XCNT(j)]); sum += c; cnt += (c > 0u) ? 1u : 0u; mine = (j == x) ? c : mine; }
        if (sum == G) break;
        __builtin_amdgcn_s_sleep(1);
        if ((++sp & 255u) == 0u) { if (xb_ld(&bar[XB_TMO])) break; if (sp > XB_SPIN_CAP) { atomicAdd(&bar[XB_TMO], 1u); break; } }
    }
    nloc = mine > 0u ? mine : 1u; nx = cnt > 0u ? cnt : 1u;
}

__device__ __forceinline__ void xcd_barrier(const XcdBarrier& b) {
    asm volatile("s_waitcnt vmcnt(0)" ::: "memory");
    __syncthreads();
    if (threadIdx.x == 0) {
        unsigned* bar = b.bar;
        __builtin_amdgcn_s_waitcnt(0);
        unsigned nloc = b.st[0], nx = b.st[1];
        if (nloc == 0u) { xcd_barrier_complete(bar, b.x, nloc, nx); b.st[0] = nloc; b.st[1] = nx; }
        const unsigned old = xb_add(&bar[XB_XSUB(b.x)], 1u);
        const unsigned gen = old / nloc;
        if (old + 1u == (gen + 1u) * nloc) {
            __builtin_amdgcn_fence(__ATOMIC_RELEASE, "agent");
            asm volatile("s_waitcnt vmcnt(0)" ::: "memory");
            const unsigned og = xb_add(&bar[XB_TOP], 1u);
            const unsigned tg = og / nx;
            if (og + 1u == (tg + 1u) * nx) xb_add(&bar[XB_TOPGEN], 1u);
            else XB_SPIN(xb_ld(&bar[XB_TOPGEN]) == tg, bar);
            __builtin_amdgcn_fence(__ATOMIC_ACQUIRE, "agent");
            xb_add(&bar[XB_XGEN(b.x)], 1u);
            asm volatile("s_waitcnt vmcnt(0)" ::: "memory");
        } else {
            XB_SPIN(xb_ld(&bar[XB_XGEN(b.x)]) == gen, bar);
            __builtin_amdgcn_fence(__ATOMIC_ACQUIRE, "agent");
            asm volatile("s_waitcnt vmcnt(0)" ::: "memory");
        }
    }
    __syncthreads();
}

struct Args { const float* in[18]; float* out; unsigned char* ws; };
__global__ void __launch_bounds__(NTHR, 2) fwd_kernel(Args a) {
    extern __shared__ __attribute__((aligned(16))) unsigned char lds_raw[];
    LAS unsigned char* lds = (LAS unsigned char*)lds_raw;
    cg::grid_group grid = cg::this_grid();
    if (threadIdx.x < 2) ((volatile LAS unsigned*)(lds + LDS_BARST))[threadIdx.x] = 0u;
    if (a.ws == nullptr) grid.sync();
    { unsigned* bw = (unsigned*)(a.ws + WS_BAR); unsigned* rdy = bw + 4000;
      if (blockIdx.x == 0) { for (int i = threadIdx.x; i < XCD_BAR_WORDS; i += NTHR) __hip_atomic_store(bw + i, 0u, __ATOMIC_RELAXED, __HIP_MEMORY_SCOPE_AGENT);
          asm volatile("s_waitcnt vmcnt(0)" ::: "memory"); __syncthreads();
          if (threadIdx.x == 0) { __builtin_amdgcn_fence(__ATOMIC_RELEASE, "agent"); __hip_atomic_store(rdy, 0x5EEDBA55u, __ATOMIC_RELAXED, __HIP_MEMORY_SCOPE_AGENT); } }
      if (threadIdx.x == 0) { unsigned spins = 0u;
          while (__hip_atomic_load(rdy, __ATOMIC_RELAXED, __HIP_MEMORY_SCOPE_AGENT) != 0x5EEDBA55u && ++spins < (1u << 22)) __builtin_amdgcn_s_sleep(2);
          __builtin_amdgcn_fence(__ATOMIC_ACQUIRE, "agent");
          ((volatile LAS unsigned*)(lds + LDS_BARST + 16))[0] = xb_add(&bw[XB_XCNT(xb_xcc_id())], 1u); }
      __syncthreads(); }
    const int G = gridDim.x, bid = blockIdx.x; const int NGW = G * 8, NGT = G * NTHR;
#define PHASE_IDS KP_DECL int tid = threadIdx.x; asm volatile("" : "+v"(tid)); const int lane = tid & 63; const int wid = __builtin_amdgcn_readfirstlane(tid >> 6); const int gw = bid * 8 + wid; const int gt = bid * NTHR + tid; (void)gw; (void)gt; (void)lane;
    typedef const __attribute__((address_space(4))) unsigned char* kargp_t;
#define KP_DECL kargp_t kp_ = (kargp_t)__builtin_amdgcn_kernarg_segment_ptr(); asm volatile("" : "+s"(kp_));
#define KIN(i) (*(const __attribute__((address_space(4))) float* const __attribute__((address_space(4)))*)(kp_ + 8 * (i)))
#define KPTR(i) (*(unsigned char* const __attribute__((address_space(4)))*)(kp_ + 8 * (i)))
#define x_prompt ((const float*)KPTR(0))
#define x_sample ((const float*)KPTR(1))
#define state_conv ((const float*)KPTR(2))
#define state_gla ((const float*)KPTR(3))
#define state_ffn ((const float*)KPTR(4))
#define norm_mix_g ((const float*)KPTR(5))
#define w_in ((const float*)KPTR(6))
#define conv_w ((const float*)KPTR(7))
#define gate_w2 ((const float*)KPTR(8))
#define gate_b ((const float*)KPTR(9))
#define gla_norm_g ((const float*)KPTR(10))
#define w_out ((const float*)KPTR(11))
#define norm_ffn_g ((const float*)KPTR(12))
#define w_up ((const float*)KPTR(13))
#define ffn_conv_w ((const float*)KPTR(14))
#define ffn_conv_b ((const float*)KPTR(15))
#define w_down ((const float*)KPTR(16))
#define final_norm_g ((const float*)KPTR(17))
#define out ((float*)KPTR(18))
#define ws (KPTR(19))
#define WT_IN ((bf16_t*)(ws + WS_WIN))
#define WT_OUT ((bf16_t*)(ws + WS_WOUT))
#define WT_UP ((bf16_t*)(ws + WS_WUP))
#define WT_DN ((bf16_t*)(ws + WS_WDN))
#define XN ((bf16_t*)(ws + WS_XN))
#define XR ((float*)(ws + WS_XR))
#define PR ((bf16_t*)(ws + WS_PR))
#define UC ((float*)(ws + WS_UC))
#define Y ((bf16_t*)(ws + WS_Y))
#define SUB ((bf16_t*)(ws + WS_SU))
#define EB ((float*)(ws + WS_EB))
#define QT ((bf16_t*)(ws + WS_QT))
#define AM ((bf16_t*)(ws + WS_AM))
#define PRS ((float*)(ws + WS_PRS))
#define GLRP ((float*)(ws + WS_GLRP))
#define XSP ((float*)(ws + WS_XSP))
#define H ((bf16_t*)(ws + WS_H))
#define TAIL ((float*)(ws + WS_TAIL))
#define SSB ((float*)(ws + WS_SS))
#define SSP ((float*)(ws + WS_SSP))
#define HEAD ((float*)(ws + WS_HEAD))

    for (int rp_ = 0; rp_ < REP_P0; ++rp_) {
        PHASE_IDS
        LAS float* scr = (LAS float*)(lds + wid * 16384);
#if P0_WG
        { const P0Src ts{w_in, w_out, w_up, w_down, norm_mix_g, norm_ffn_g, WT_IN, WT_OUT, WT_UP, WT_DN}; LAS float* T = (LAS float*)lds;
          int it = bid; P0Desc dc, dn; f32x4 tv[8];
          bool have = p0_decode(it, ts, wid, lane, dc); if (have) p0_load(dc, tv);
          while (have) {
              p0_to_lds(dc, tv, T, wid, lane);
              __syncthreads();
              const bool hn = p0_decode(it + G, ts, wid, lane, dn); if (hn) p0_load(dn, tv);
              p0_out(dc, T, wid, lane);
              __syncthreads();
              have = hn; it += G; dc = dn;
          } }
#else
        constexpr int I_IN = 200 * 32, I_OUT = 64 * 32, I_UP = 352 * 32, I_DN = 64 * 88, I_L = I_IN + I_OUT + I_UP + I_DN;
        for (int it = gw; it < 2 * I_L; it += NGW) {
            const int l = it / I_L; int rr = it - l * I_L;
            if (rr < I_IN) { const int g = rr >> 5, kb = rr & 31; int src, nv; bool perm; win_map(g, src, nv, perm);
                tr_item(w_in + (size_t)l * DM * INC, INC, nv, DM, WT_IN + (size_t)l * INP * DM, g * 32, src, perm, kb, scr, lane, norm_mix_g + (size_t)l * DM); continue; }
            rr -= I_IN;
            if (rr < I_OUT) { const int g = rr >> 5, kb = rr & 31; tr_item(w_out + (size_t)l * DM * DM, DM, DM, DM, WT_OUT + (size_t)l * DM * DM, g * 32, g * 32, false, kb, scr, lane); continue; }
            rr -= I_OUT;
            if (rr < I_UP) { const int g = rr >> 5, kb = rr & 31; const int tile = g >> 3, gi = g & 7; const int src = (gi < 4) ? (128 * tile + 32 * gi) : (DFF + 128 * tile + 32 * (gi - 4));
                tr_item(w_up + (size_t)l * DM * UPN, UPN, UPN, DM, WT_UP + (size_t)l * UPN * DM, g * 32, src, true, kb, scr, lane, norm_ffn_g + (size_t)l * DM); continue; }
            rr -= I_UP;
            { const int g = rr / 88, kb = rr - g * 88; tr_item(w_down + (size_t)l * DFF * DM, DM, DM, DFF, WT_DN + (size_t)l * DM * DFF, g * 32, g * 32, false, kb, scr, lane); }
        }
#endif
        for (int m = gw; m < MPAD; m += NGW) {
            if (m < MREAL) row_bf16_ss(m < MP ? x_prompt + (size_t)m * DM : x_sample + (size_t)(m - MP) * DM, XN + (size_t)m * DM, SSB + m, lane);
            else { u32x4* o = (u32x4*)(XN + (size_t)m * DM) + lane; const u32x4 z = {0u, 0u, 0u, 0u};
#pragma unroll
                for (int j = 0; j < 4; ++j) o[64 * j] = z;
                if (lane == 0) SSB[m] = 0.f; }
        }
        for (int i = gt; i < 3 * MPAD; i += NGT) SSB[MPAD + i] = 0.f;
    }
    unsigned* barw_; { KP_DECL barw_ = (unsigned*)(ws + WS_BAR); }
    XcdBarrier xbar; xbar.bar = barw_; xbar.x = xb_xcc_id(); xbar.st = (volatile LAS unsigned*)(lds + LDS_BARST);
#define GRID_BAR() xcd_barrier(xbar)
    volatile LAS unsigned* vcw = (volatile LAS unsigned*)(lds + LDS_BARST + 16);
    GRID_BAR();
    if (threadIdx.x == 0) { bool even = (G == 256);
        for (unsigned j = 0; j < 8; ++j) even = even && (xb_ld(&barw_[XB_XCNT(j)]) == 32u);
        vcw[1] = even ? vcw[0] * 8u + xbar.x : (unsigned)bid; }
    __syncthreads();
    const int vcu = __builtin_amdgcn_readfirstlane((int)vcw[1]);

#pragma unroll 1
    for (int l = 0; l < 2; ++l) {
        for (int rp_ = 0; rp_ < REP_G1; ++rp_) { KP_DECL pg8::Gemm g{XN, WT_IN + (size_t)l * INP * DM, MPAD, INP, DM}; MixOrder<1> S; S.init(6144, 32, G, vcu);
          EpiIn E{PR, UC, GLRP, PRS, SSB + (size_t)(2 * l) * MPAD, out + O_CP + (size_t)l * NBATCH * 2 * CONVD};
          pg8::gemm_phase<EpiIn, MixOrder<1>, true, true>(lds, g, S, E); }
        GRID_BAR();
        for (int rp_ = 0; rp_ < REP_M1; ++rp_) {
            PHASE_IDS
            const float* w2 = gate_w2 + (size_t)l * RANK * QKD; const float* gb = gate_b + (size_t)l * QKD; const float* gn = gla_norm_g + (size_t)l * 1024;
            for (int ra_ = 0; ra_ < REP_M1A; ++ra_) for (int u = bid; u < 512; u += G) gla_passA(lds, u, PR, GLRP, w2, gb, SUB, EB, QT, AM, tid, wid, lane);
            for (int rs_ = 0; rs_ < REP_M1S; ++rs_) for (int u = bid; u < 512; u += G) gla_sample<true>(lds, u, PRS, GLRP, w2, gb, gn, state_gla + (size_t)l * NS * NH * DK * DV, out + O_GS + (size_t)l * NS * NH * DK * DV, Y, tid, wid, lane);
            const float* cw = conv_w + (size_t)l * 3 * CONVD;
            for (int rc_ = 0; rc_ < REP_M1C; ++rc_) for (int item = gt; item < (MP / 16) * 256; item += NGT) {
                const int c4 = (item & 255) * 4, row0 = (item >> 8) * 16; const bool cont = (row0 & (SEQ - 1)) != 0; const bf16_t* up = (const bf16_t*)UC + (size_t)row0 * CONVD + c4; const f32x4 z = {0.f, 0.f, 0.f, 0.f};
                f32x4 u[18]; u32x2 bg[16];
                u32x2 ub[18]; ub[0] = cont ? *(const u32x2*)(up - 2 * CONVD) : (u32x2){0u, 0u}; ub[1] = cont ? *(const u32x2*)(up - CONVD) : (u32x2){0u, 0u};
#pragma unroll
                for (int i = 0; i < 16; ++i) { ub[2 + i] = *(const u32x2*)(up + (size_t)i * CONVD); bg[i] = *(const u32x2*)(PR + (size_t)(row0 + i) * PRW + c4); }
                const f32x4 w0 = *(const f32x4*)(cw + c4), w1 = *(const f32x4*)(cw + CONVD + c4), w2v = *(const f32x4*)(cw + 2 * CONVD + c4);
#pragma unroll
                for (int i = 0; i < 18; ++i) u[i] = (f32x4){bf_lo(ub[i].x), bf_hi(ub[i].x), bf_lo(ub[i].y), bf_hi(ub[i].y)};
#pragma unroll
                for (int i = 0; i < 16; ++i) { const f32x4 bgf = {bf_lo(bg[i].x), bf_hi(bg[i].x), bf_lo(bg[i].y), bf_hi(bg[i].y)};
                    const f32x4 cu = (u[i] * w0 + u[i + 1] * w1 + u[i + 2] * w2v) * bgf;
                    u32x2 w; w.x = cvt_pk_bf16(cu.x, cu.y); w.y = cvt_pk_bf16(cu.z, cu.w);
                    *(u32x2*)(Y + (size_t)(row0 + i) * DM + c4) = w; }
            }
            for (int idx = gt; idx < NS * 256; idx += NGT) { const int s = idx >> 8, c4 = (idx & 255) * 4; const int row = MP + s;
                const f32x4 u0 = prs_sum4(PRS, s, 1024 + c4) * prs_sum4(PRS, s, 2048 + c4), bgf = prs_sum4(PRS, s, c4);
                const float* sp = state_conv + ((size_t)l * NS + s) * 2 * CONVD + c4; const f32x4 u2 = *(const f32x4*)sp, u1 = *(const f32x4*)(sp + CONVD);
                float* op = out + O_CS + ((size_t)l * NS + s) * 2 * CONVD + c4; *(f32x4*)op = u1; *(f32x4*)(op + CONVD) = u0;
                const f32x4 w0 = *(const f32x4*)(cw + c4), w1 = *(const f32x4*)(cw + CONVD + c4), w2v = *(const f32x4*)(cw + 2 * CONVD + c4);
                const f32x4 cu = (u2 * w0 + u1 * w1 + u0 * w2v) * bgf;
                u32x2 w; w.x = cvt_pk_bf16(cu.x, cu.y); w.y = cvt_pk_bf16(cu.z, cu.w);
                *(u32x2*)(Y + (size_t)row * DM + c4) = w; }
        }
        GRID_BAR();
        { PHASE_IDS
        for (int e = gt; e < 16 * DK * 64; e += NGT) { const int bh = e >> 13, rem = e & 8191, k = rem >> 6, dq = rem & 63;
            bf16_t* sp = SUB + (size_t)bh * NCH * (DK * DV) + k * DV + 4 * dq; const float* ep = EB + (size_t)bh * NCH * DK + k; f32x4 S = {0.f, 0.f, 0.f, 0.f};
#pragma unroll 1
            for (int c0 = 0; c0 < NCH; c0 += 16) { u32x2 uu[16]; float ee[16];
#pragma unroll
                for (int i = 0; i < 16; ++i) { uu[i] = *(const u32x2*)(sp + (size_t)(c0 + i) * (DK * DV)); ee[i] = ep[(c0 + i) * DK]; }
#pragma unroll
                for (int i = 0; i < 16; ++i) { u32x2 w; w.x = cvt_pk_bf16(S.x, S.y); w.y = cvt_pk_bf16(S.z, S.w); *(u32x2*)(sp + (size_t)(c0 + i) * (DK * DV)) = w;
                    S = S * ee[i] + (f32x4){bf_lo(uu[i].x), bf_hi(uu[i].x), bf_lo(uu[i].y), bf_hi(uu[i].y)}; } }
            *(f32x4*)(out + O_GP + ((size_t)l * 16 + bh) * (DK * DV) + k * DV + 4 * dq) = S; } }
        GRID_BAR();
        for (int rp_ = 0; rp_ < REP_M3; ++rp_) { PHASE_IDS const float* gn = gla_norm_g + (size_t)l * 1024; for (int u = bid; u < 512; u += G) gla_passC(lds, u, PR, SUB, QT, AM, gn, Y, tid, wid, lane); }
        GRID_BAR();
        { KP_DECL pg8::Gemm g{Y, WT_OUT + (size_t)l * DM * DM, MPAD, DM, DM}; MixOrder<2> S; S.init(DM, 32, G, vcu);
          EpiRes E{l == 0 ? x_prompt : nullptr, nullptr, XSP, XN, SSP};
          pg8::gemm_phase<EpiRes, MixOrder<2>, true, true>(lds, g, S, E); }
        GRID_BAR();
        for (int rp_ = 0; rp_ < REP_NRM; ++rp_) { PHASE_IDS
              for (int r = gt; r < MP; r += NGT) { const f32x4* sp = (const f32x4*)(SSP + (size_t)r * 32); f32x4 t = sp[0];
#pragma unroll
                  for (int j = 1; j < 8; ++j) t += sp[j];
                  SSB[(size_t)(2 * l + 1) * MPAD + r] = (t.x + t.y) + (t.z + t.w); }
              for (int m = MP + gw; m < MREAL; m += NGW) {
                  if (rp_ == 0) sample_assemble(l == 0 ? x_sample + (size_t)(m - MP) * DM : XR + (size_t)m * DM, XSP, 8, m - MP, XR + (size_t)m * DM, lane);
                  row_bf16_ss(XR + (size_t)m * DM, XN + (size_t)m * DM, SSB + (size_t)(2 * l + 1) * MPAD + m, lane); } }
        GRID_BAR();
        for (int rp_ = 0; rp_ < REP_UP; ++rp_) { KP_DECL pg8::Gemm g{XN, WT_UP + (size_t)l * UPN * DM, MPAD, UPN, DM}; MixOrder<3> S; S.init(UPN, 32, G, vcu);
          EpiUp E{H, ffn_conv_w + (size_t)l * 3 * DFF, ffn_conv_b + (size_t)l * DFF, TAIL, HEAD, state_ffn + (size_t)l * NS * 2 * DFF, out + O_FP + (size_t)l * NBATCH * 2 * DFF, out + O_FS + (size_t)l * NS * 2 * DFF, (LAS float*)(lds + LDS_HALO), SSB + (size_t)(2 * l + 1) * MPAD};
          pg8::gemm_phase<EpiUp, MixOrder<3>, true, true>(lds, g, S, E); }
        {
            PHASE_IDS const int first = (G == 256) ? 172 : 0, nw = G - first;
            const float* w2 = gate_w2 + (size_t)l * RANK * QKD; const float* gb = gate_b + (size_t)l * QKD;
            if (DEFER_STATE && bid >= first) for (int u = bid - first; u < 512; u += nw) gla_sample<false>(lds, u, PRS, GLRP, w2, gb, nullptr, state_gla + (size_t)l * NS * NH * DK * DV, out + O_GS + (size_t)l * NS * NH * DK * DV, nullptr, tid, wid, lane);
        }
        GRID_BAR();
        { PHASE_IDS MixOrder<4> S0; S0.init(DM, 88, G, vcu); pg8::Unit u0;
          for (int ui = 0; S0.next(ui, u0); ++ui) if (u0.sp < 0 && (u0.pm & 7) != 0) { const int pm = u0.pm; const float* cw = ffn_conv_w + (size_t)l * 3 * DFF; const float* cb = ffn_conv_b + (size_t)l * DFF;
            for (int idx = tid; idx < 2 * (DFF / 4); idx += NTHR) { const int j = idx / (DFF / 4), c4 = (idx - j * (DFF / 4)) * 4;
              const f32x4 t0 = *(const f32x4*)(TAIL + ((size_t)(pm - 1) * 2 + 0) * DFF + c4), t1 = *(const f32x4*)(TAIL + ((size_t)(pm - 1) * 2 + 1) * DFF + c4);
              const f32x4 hu0 = *(const f32x4*)(HEAD + ((size_t)pm * 2 + 0) * 2 * DFF + c4), hu1 = *(const f32x4*)(HEAD + ((size_t)pm * 2 + 1) * 2 * DFF + c4), hv = *(const f32x4*)(HEAD + ((size_t)pm * 2 + j) * 2 * DFF + DFF + c4);
              const f32x4 w0 = *(const f32x4*)(cw + c4), w1 = *(const f32x4*)(cw + DFF + c4), w2v = *(const f32x4*)(cw + 2 * DFF + c4), bv = *(const f32x4*)(cb + c4);
              const f32x4 cu = j == 0 ? (t0 * w0 + t1 * w1 + hu0 * w2v + bv) : (t1 * w0 + hu0 * w1 + hu1 * w2v + bv);
              u32x2 w; w.x = cvt_pk_bf16(silu_f(cu.x) * hv.x, silu_f(cu.y) * hv.y); w.y = cvt_pk_bf16(silu_f(cu.z) * hv.z, silu_f(cu.w) * hv.w);
              *(u32x2*)(H + (size_t)(pm * 256 + j) * DFF + c4) = w; }
            asm volatile("s_waitcnt vmcnt(0)" ::: "memory"); }
          __syncthreads(); }
        { KP_DECL pg8::Gemm g{H, WT_DN + (size_t)l * DM * DFF, MPAD, DM, DFF}; MixOrder<4> S; S.init(DM, 88, G, vcu);
          EpiRes E{nullptr, nullptr, XSP, XN, l == 0 ? SSP : nullptr};
          pg8::gemm_phase<EpiRes, MixOrder<4>, true, true>(lds, g, S, E); }
        GRID_BAR();
        if (l == 0) { PHASE_IDS
              for (int r = gt; r < MP; r += NGT) { const f32x4* sp = (const f32x4*)(SSP + (size_t)r * 32); f32x4 t = sp[0];
#pragma unroll
                  for (int j = 1; j < 8; ++j) t += sp[j];
                  SSB[(size_t)2 * MPAD + r] = (t.x + t.y) + (t.z + t.w); }
              for (int m = MP + gw; m < MREAL; m += NGW) { sample_assemble(XR + (size_t)m * DM, XSP, 11, m - MP, XR + (size_t)m * DM, lane);
                  row_bf16_ss(XR + (size_t)m * DM, XN + (size_t)m * DM, SSB + (size_t)2 * MPAD + m, lane); }
            GRID_BAR(); }
    }
    PHASE_IDS
    if (bid == 0 && tid == 0) __hip_atomic_store((unsigned*)(ws + WS_BAR) + 4000, 0u, __ATOMIC_RELAXED, __HIP_MEMORY_SCOPE_AGENT);
    for (int m = gw; m < MREAL; m += NGW) {
        if (m >= MP) { sample_assemble(XR + (size_t)m * DM, XSP, 11, m - MP, XR + (size_t)m * DM, lane); rms_row_f32(XR + (size_t)m * DM, final_norm_g, out + O_YS + (size_t)(m - MP) * DM, lane); }
        else { const u32x2* xr = (const u32x2*)(XN + (size_t)m * DM) + lane; f32x4 v[8]; float sq = 0.f;
#pragma unroll
            for (int j = 0; j < 8; ++j) { const u32x2 w = xr[64 * j]; v[j] = (f32x4){bf_lo(w.x), bf_hi(w.x), bf_lo(w.y), bf_hi(w.y)}; sq += (v[j].x * v[j].x + v[j].y * v[j].y) + (v[j].z * v[j].z + v[j].w * v[j].w); }
            const float rstd = rsqrtf(wave_sum(sq) * (1.f / DM) + EPS); const f32x4* gr = (const f32x4*)final_norm_g + lane; f32x4* o = (f32x4*)(out + O_YP + (size_t)m * DM) + lane;
#pragma unroll
            for (int j = 0; j < 8; ++j) o[64 * j] = v[j] * rstd * gr[64 * j]; } }
}

#undef x_prompt
#undef x_sample
#undef state_conv
#undef state_gla
#undef state_ffn
#undef norm_mix_g
#undef w_in
#undef conv_w
#undef gate_w2
#undef gate_b
#undef gla_norm_g
#undef w_out
#undef norm_ffn_g
#undef w_up
#undef ffn_conv_w
#undef ffn_conv_b
#undef w_down
#undef final_norm_g
#undef out
#undef ws
#undef WT_IN
#undef WT_OUT
#undef WT_UP
#undef WT_DN
#undef XN
#undef XR
#undef PR
#undef UC
#undef Y
#undef SUB
#undef EB
#undef QT
#undef AM
#undef PRS
#undef GLRP
#undef XSP
#undef H
#undef TAIL
#undef SSB
#undef SSP
#undef HEAD
extern "C" void kernel_launch(void* const* d_in, const int* in_sizes, int n_in, void* d_out, int out_size, void* d_ws, size_t ws_size, hipStream_t stream) {
    static int grid = 0;
    if (grid == 0) {
        if (n_in != 18 || (size_t)out_size != O_TOTAL || ws_size < WS_TOTAL) { fprintf(stderr, "kernel_launch: unexpected shapes: n_in %d out %d ws %zu (need %zu)\n", n_in, out_size, ws_size, (size_t)WS_TOTAL); grid = -1; return; }
        int dev = 0, cus = 0, per_cu = 0;
        hipGetDevice(&dev); hipDeviceGetAttribute(&cus, hipDeviceAttributeMultiprocessorCount, dev);
        if (hipFuncSetAttribute((const void*)fwd_kernel, hipFuncAttributeMaxDynamicSharedMemorySize, LDS_BYTES) != hipSuccess) { fprintf(stderr, "kernel_launch: hipFuncSetAttribute failed\n"); grid = -1; return; }
        if (hipOccupancyMaxActiveBlocksPerMultiprocessor(&per_cu, (const void*)fwd_kernel, NTHR, LDS_BYTES) != hipSuccess || per_cu < 1) { fprintf(stderr, "kernel_launch: occupancy query says %d\n", per_cu); per_cu = 1; }
        (void)hipGetLastError();
        grid = cus;
    }
    if (grid < 0) return;
    Args a{};
    for (int i = 0; i < 18; ++i) a.in[i] = (const float*)d_in[i];
    a.out = (float*)d_out; a.ws = (unsigned char*)d_ws;
    void* args[] = {&a};
    hipError_t e = hipLaunchCooperativeKernel((const void*)fwd_kernel, dim3(grid), dim3(NTHR), args, LDS_BYTES, stream);
    if (e != hipSuccess) fprintf(stderr, "kernel_launch: cooperative launch failed: %s (grid %d)\n", hipGetErrorString(e), grid);
}
```
